# Optimizing an MI355X kernel written in HIP

```python
import jax, jax.numpy as jnp
from jax import lax
import numpy as np

D_MODEL = 2048
BATCH = 2
SEQ = 4096
DEPTH = 1
DEC_BATCH = 16
DEC_SEQ = 32
PAST_LEN = 4096

CHUNK = 64
Q_BLOCK = 128
D_FF = 5632
NORM_EPS = 1e-6
GDN_HEADS = 8
GDN_DK = 128
GDN_DV = 128
GDN_CONV = 4
GDN_CHUNK = 64
GDN_KEY_DIM = GDN_HEADS * GDN_DK
GDN_VAL_DIM = GDN_HEADS * GDN_DV
GDN_CONV_DIM = 2 * GDN_KEY_DIM + GDN_VAL_DIM
MLA_HEADS = 8
MLA_NOPE = 128
MLA_ROPE = 64
MLA_V = 128
MLA_KV_RANK = 512
MLA_SCALE = (MLA_NOPE + MLA_ROPE) ** -0.5
ROPE_THETA = 10000.0
IN_SPLIT_SIZES = (GDN_CONV_DIM, GDN_VAL_DIM, GDN_HEADS, GDN_HEADS,
                  MLA_HEADS * (MLA_NOPE + MLA_ROPE), MLA_KV_RANK, MLA_ROPE,
                  D_MODEL, D_MODEL)
IN_SPLITS = tuple(int(s) for s in np.cumsum(IN_SPLIT_SIZES)[:-1])
D_IN = int(sum(IN_SPLIT_SIZES))

kernel_name = 'hybrid_gdn_mla_streaming_step'


def rmsnorm(x, g):
    xf = x.astype(jnp.float32)
    y = xf * lax.rsqrt(jnp.mean(xf * xf, axis=-1, keepdims=True) + NORM_EPS)
    return (y * g.astype(jnp.float32)).astype(x.dtype)


def l2norm(x):
    return x * lax.rsqrt(jnp.sum(x * x, axis=-1, keepdims=True) + 1e-6)


def swiglu(x, wg, wu, wd):
    return (jax.nn.silu(x @ wg) * (x @ wu)) @ wd


def rope_tables(pos):
    inv = ROPE_THETA ** (-jnp.arange(0, MLA_ROPE, 2, dtype=jnp.float32) / MLA_ROPE)
    ang = pos.astype(jnp.float32)[:, None] * inv[None, :]
    return jnp.cos(ang), jnp.sin(ang)


def apply_rope(x, cos, sin):
    xf = x.astype(jnp.float32)
    x1, x2 = jnp.split(xf, 2, axis=-1)
    return jnp.concatenate([x1 * cos - x2 * sin, x2 * cos + x1 * sin], axis=-1).astype(x.dtype)


def causal_conv(x, hist, w):
    T = x.shape[1]
    xp = jnp.concatenate([hist.astype(x.dtype), x], axis=1)
    y = xp[:, 0:T] * w[0]
    for j in range(1, GDN_CONV):
        y = y + xp[:, j:j + T] * w[j]
    return jax.nn.silu(y), xp[:, -(GDN_CONV - 1):]


def gdn_chunked(q, k, v, g, beta, s0):
    B, T, H, DK = q.shape
    DV = v.shape[-1]
    C = GDN_CHUNK
    pad = (-T) % C
    n = (T + pad) // C

    def blocks(a):
        a = jnp.pad(a, [(0, 0), (0, pad)] + [(0, 0)] * (a.ndim - 2))
        a = a.reshape((B, n, C) + a.shape[2:])
        return jnp.moveaxis(a, 3, 2).swapaxes(0, 1)

    idx = jnp.arange(C)
    incl = idx[:, None] >= idx[None, :]
    strict = idx[:, None] > idx[None, :]
    eye = jnp.eye(C, dtype=jnp.float32)

    def step(S, blk):
        qc, kc, vc, gc, bc = blk
        gcum = jnp.cumsum(gc, axis=-1)
        diff = gcum[..., :, None] - gcum[..., None, :]
        decay = jnp.where(incl, jnp.exp(jnp.where(incl, diff, 0.0)), 0.0)
        kk = jnp.einsum('bhik,bhjk->bhij', kc, kc)
        a_mat = eye + jnp.where(strict, bc[..., :, None] * kk * decay, 0.0)
        rhs = jnp.concatenate([vc * bc[..., None],
                               kc * (bc * jnp.exp(gcum))[..., None]], axis=-1)
        sol = lax.linalg.triangular_solve(a_mat, rhs, left_side=True, lower=True,
                                          unit_diagonal=True)
        u, w = sol[..., :DV], sol[..., DV:]
        v_new = u - jnp.einsum('bhck,bhkv->bhcv', w, S)
        qk = jnp.einsum('bhik,bhjk->bhij', qc, kc) * decay
        o = (jnp.einsum('bhik,bhkv->bhiv', qc * jnp.exp(gcum)[..., None], S)
             + jnp.einsum('bhij,bhjv->bhiv', qk, v_new))
        g_last = gcum[..., -1:]
        S_new = (S * jnp.exp(g_last)[..., None]
                 + jnp.einsum('bhck,bhcv->bhkv', kc * jnp.exp(g_last - gcum)[..., None], v_new))
        return S_new, o

    s_final, o = lax.scan(step, s0, (blocks(q), blocks(k), blocks(v), blocks(g), blocks(beta)))
    o = jnp.moveaxis(o.swapaxes(0, 1), 2, 3).reshape(B, n * C, H, DV)[:, :T]
    return o, s_final


def mla_attend(q_lat, q_rope, ckv, krope, q_pos, k_pos):
    s = (jnp.einsum('bqhc,bkc->bhqk', q_lat, ckv)
         + jnp.einsum('bqhr,bkr->bhqk', q_rope, krope)).astype(jnp.float32) * MLA_SCALE
    mask = (q_pos[:, None] // CHUNK) >= (k_pos[None, :] // CHUNK)
    p = jax.nn.softmax(jnp.where(mask, s, -jnp.inf), axis=-1).astype(ckv.dtype)
    return jnp.einsum('bhqk,bkc->bqhc', p, ckv)


def token_mixer(h, pos, conv_hist, ssm0, ckv_past, krope_past, p):
    B, T, _ = h.shape
    proj = h @ p['w_in']
    qkv, z, b_raw, a_raw, q_mla, ckv_raw, krope_raw, gate_gdn, gate_mla = jnp.split(
        proj, IN_SPLITS, axis=-1)

    qkv_c, conv_new = causal_conv(qkv, conv_hist, p['gdn_conv_w'])
    q, k, v = jnp.split(qkv_c.astype(jnp.float32), [GDN_KEY_DIM, 2 * GDN_KEY_DIM], axis=-1)
    q = l2norm(q.reshape(B, T, GDN_HEADS, GDN_DK)) * (GDN_DK ** -0.5)
    k = l2norm(k.reshape(B, T, GDN_HEADS, GDN_DK))
    v = v.reshape(B, T, GDN_HEADS, GDN_DV)
    beta = jax.nn.sigmoid(b_raw.astype(jnp.float32))
    g = -jnp.exp(p['gdn_a_log'].astype(jnp.float32)) * jax.nn.softplus(
        a_raw.astype(jnp.float32) + p['gdn_dt_bias'].astype(jnp.float32))
    o, ssm_new = gdn_chunked(q, k, v, g, beta, ssm0.astype(jnp.float32))
    o = rmsnorm(o, p['gdn_norm_w']) * jax.nn.silu(
        z.reshape(B, T, GDN_HEADS, GDN_DV).astype(jnp.float32))
    o_gdn = o.reshape(B, T, GDN_VAL_DIM).astype(h.dtype)

    cos, sin = rope_tables(pos)
    q_mla = q_mla.reshape(B, T, MLA_HEADS, MLA_NOPE + MLA_ROPE)
    q_nope = q_mla[..., :MLA_NOPE]
    q_rope = apply_rope(q_mla[..., MLA_NOPE:], cos[:, None, :], sin[:, None, :])
    ckv = rmsnorm(ckv_raw, p['mla_kv_norm'])
    krope = apply_rope(krope_raw, cos, sin)
    q_lat = jnp.einsum('bthd,chd->bthc', q_nope, p['mla_w_uk'])
    if ckv_past is None:
        nq = T // Q_BLOCK

        def to_blocks(a):
            return a.reshape((B, nq, Q_BLOCK) + a.shape[2:]).swapaxes(0, 1)

        out_lat = lax.map(
            lambda blk: mla_attend(blk[0], blk[1], ckv, krope, blk[2], pos),
            (to_blocks(q_lat), to_blocks(q_rope), pos.reshape(nq, Q_BLOCK)))
        out_lat = out_lat.swapaxes(0, 1).reshape(B, T, MLA_HEADS, MLA_KV_RANK)
    else:
        past = ckv_past.shape[1]
        ckv_all = jnp.concatenate([ckv_past.astype(ckv.dtype), ckv], axis=1)
        krope_all = jnp.concatenate([krope_past.astype(krope.dtype), krope], axis=1)
        out_lat = mla_attend(q_lat, q_rope, ckv_all, krope_all, pos,
                             jnp.arange(past + T, dtype=jnp.int32))
    o_mla = jnp.einsum('bthc,chd->bthd', out_lat, p['mla_w_uv']).reshape(B, T, MLA_HEADS * MLA_V)

    merged = (jax.nn.sigmoid(gate_gdn) * (o_gdn @ p['w_br_gdn'])
              + jax.nn.sigmoid(gate_mla) * (o_mla @ p['w_br_mla']))
    return merged @ p['w_out'], conv_new, ssm_new.astype(ssm0.dtype), ckv, krope


def trunk_layer(x, pos, conv_hist, ssm0, ckv_past, krope_past, p):
    x = x + 0.5 * rmsnorm(swiglu(rmsnorm(x, p['ffn1_norm_pre']), p['ffn1_w_gate'],
                                 p['ffn1_w_up'], p['ffn1_w_down']), p['ffn1_norm_post'])
    m, conv_new, ssm_new, ckv, krope = token_mixer(
        rmsnorm(x, p['mix_norm_pre']), pos, conv_hist, ssm0, ckv_past, krope_past, p)
    x = x + rmsnorm(m, p['mix_norm_post'])
    x = x + 0.5 * rmsnorm(swiglu(rmsnorm(x, p['ffn2_norm_pre']), p['ffn2_w_gate'],
                                 p['ffn2_w_up'], p['ffn2_w_down']), p['ffn2_norm_post'])
    return x, conv_new, ssm_new, ckv, krope


def setup_inputs(seed: int = 0) -> dict:
    key = jax.random.key(seed)
    ks = iter(jax.random.split(key, 32))
    f32 = jnp.float32

    def nrm(shape, scale):
        return jax.random.normal(next(ks), shape, f32) * scale

    def gain(n):
        return 1.0 + 0.01 * jax.random.normal(next(ks), (DEPTH, n), f32)

    d = {}
    d['x_prompt'] = nrm((BATCH, SEQ, D_MODEL), 1.0)
    d['x_sample'] = nrm((DEC_BATCH, DEC_SEQ, D_MODEL), 1.0)
    d['state_gdn_conv'] = nrm((DEPTH, DEC_BATCH, GDN_CONV - 1, GDN_CONV_DIM), 1.0)
    d['state_gdn_ssm'] = nrm((DEPTH, DEC_BATCH, GDN_HEADS, GDN_DK, GDN_DV), 0.1)
    d['cache_mla_ckv'] = nrm((DEPTH, DEC_BATCH, PAST_LEN, MLA_KV_RANK), 1.0)
    d['cache_mla_krope'] = nrm((DEPTH, DEC_BATCH, PAST_LEN, MLA_ROPE), 1.0)
    d['ffn1_norm_pre'] = gain(D_MODEL)
    d['ffn1_w_gate'] = nrm((DEPTH, D_MODEL, D_FF), D_MODEL ** -0.5)
    d['ffn1_w_up'] = nrm((DEPTH, D_MODEL, D_FF), D_MODEL ** -0.5)
    d['ffn1_w_down'] = nrm((DEPTH, D_FF, D_MODEL), D_FF ** -0.5)
    d['ffn1_norm_post'] = gain(D_MODEL)
    d['mix_norm_pre'] = gain(D_MODEL)
    d['w_in'] = nrm((DEPTH, D_MODEL, D_IN), D_MODEL ** -0.5)
    d['gdn_conv_w'] = nrm((DEPTH, GDN_CONV, GDN_CONV_DIM), GDN_CONV ** -0.5)
    d['gdn_a_log'] = jnp.log(jax.random.uniform(next(ks), (DEPTH, GDN_HEADS), f32, 1.0, 16.0))
    dt = jax.random.uniform(next(ks), (DEPTH, GDN_HEADS), f32, 1e-3, 0.1)
    d['gdn_dt_bias'] = dt + jnp.log(-jnp.expm1(-dt))
    d['gdn_norm_w'] = gain(GDN_DV)
    d['mla_kv_norm'] = gain(MLA_KV_RANK)
    d['mla_w_uk'] = nrm((DEPTH, MLA_KV_RANK, MLA_HEADS, MLA_NOPE), MLA_KV_RANK ** -0.5)
    d['mla_w_uv'] = nrm((DEPTH, MLA_KV_RANK, MLA_HEADS, MLA_V), MLA_KV_RANK ** -0.5)
    d['w_br_gdn'] = nrm((DEPTH, GDN_VAL_DIM, D_MODEL), GDN_VAL_DIM ** -0.5)
    d['w_br_mla'] = nrm((DEPTH, MLA_HEADS * MLA_V, D_MODEL), (MLA_HEADS * MLA_V) ** -0.5)
    d['w_out'] = nrm((DEPTH, D_MODEL, D_MODEL), D_MODEL ** -0.5)
    d['mix_norm_post'] = gain(D_MODEL)
    d['ffn2_norm_pre'] = gain(D_MODEL)
    d['ffn2_w_gate'] = nrm((DEPTH, D_MODEL, D_FF), D_MODEL ** -0.5)
    d['ffn2_w_up'] = nrm((DEPTH, D_MODEL, D_FF), D_MODEL ** -0.5)
    d['ffn2_w_down'] = nrm((DEPTH, D_FF, D_MODEL), D_FF ** -0.5)
    d['ffn2_norm_post'] = gain(D_MODEL)
    return d


def reference(x_prompt, x_sample, state_gdn_conv, state_gdn_ssm, cache_mla_ckv, cache_mla_krope,
              ffn1_norm_pre, ffn1_w_gate, ffn1_w_up, ffn1_w_down, ffn1_norm_post,
              mix_norm_pre, w_in, gdn_conv_w, gdn_a_log, gdn_dt_bias, gdn_norm_w,
              mla_kv_norm, mla_w_uk, mla_w_uv, w_br_gdn, w_br_mla, w_out, mix_norm_post,
              ffn2_norm_pre, ffn2_w_gate, ffn2_w_up, ffn2_w_down, ffn2_norm_post):
    layer_params = dict(
        ffn1_norm_pre=ffn1_norm_pre, ffn1_w_gate=ffn1_w_gate, ffn1_w_up=ffn1_w_up,
        ffn1_w_down=ffn1_w_down, ffn1_norm_post=ffn1_norm_post, mix_norm_pre=mix_norm_pre,
        w_in=w_in, gdn_conv_w=gdn_conv_w, gdn_a_log=gdn_a_log, gdn_dt_bias=gdn_dt_bias,
        gdn_norm_w=gdn_norm_w, mla_kv_norm=mla_kv_norm, mla_w_uk=mla_w_uk, mla_w_uv=mla_w_uv,
        w_br_gdn=w_br_gdn, w_br_mla=w_br_mla, w_out=w_out, mix_norm_post=mix_norm_post,
        ffn2_norm_pre=ffn2_norm_pre, ffn2_w_gate=ffn2_w_gate, ffn2_w_up=ffn2_w_up,
        ffn2_w_down=ffn2_w_down, ffn2_norm_post=ffn2_norm_post)
    b_p, t_p = x_prompt.shape[0], x_prompt.shape[1]
    t_s = x_sample.shape[1]
    past = cache_mla_ckv.shape[2]
    pos_prompt = jnp.arange(t_p, dtype=jnp.int32)
    pos_sample = past + jnp.arange(t_s, dtype=jnp.int32)
    yp, ys = x_prompt, x_sample
    conv_p, ssm_p, ckv_p, krope_p = [], [], [], []
    conv_s, ssm_s, ckv_s, krope_s = [], [], [], []
    for l in range(DEPTH):
        p = {name: w[l] for name, w in layer_params.items()}
        yp, c1, s1, k1, r1 = trunk_layer(
            yp, pos_prompt, jnp.zeros((b_p, GDN_CONV - 1, GDN_CONV_DIM), yp.dtype),
            jnp.zeros((b_p, GDN_HEADS, GDN_DK, GDN_DV), state_gdn_ssm.dtype), None, None, p)
        ys, c2, s2, k2, r2 = trunk_layer(
            ys, pos_sample, state_gdn_conv[l], state_gdn_ssm[l], cache_mla_ckv[l],
            cache_mla_krope[l], p)
        conv_p.append(c1); ssm_p.append(s1); ckv_p.append(k1); krope_p.append(r1)
        conv_s.append(c2); ssm_s.append(s2); ckv_s.append(k2); krope_s.append(r2)
    return (yp, ys,
            jnp.stack(conv_p), jnp.stack(ssm_p), jnp.stack(ckv_p), jnp.stack(krope_p),
            jnp.stack(conv_s), jnp.stack(ssm_s), jnp.stack(ckv_s), jnp.stack(krope_s))
```

```cpp
#include <hip/hip_runtime.h>
#include <hip/hip_cooperative_groups.h>
#include <cstdio>
namespace cg = cooperative_groups;
namespace pg8 {
#define PG8_LAS __attribute__((address_space(3)))
typedef unsigned short bf16_t;
typedef short bf16x8 __attribute__((ext_vector_type(8)));
typedef float f32x4 __attribute__((ext_vector_type(4)));
typedef unsigned u32x4 __attribute__((ext_vector_type(4)));
constexpr int BM = 256, BK = 64, HALF = 128, HTB = HALF * BK * 2  , STAGE_BYTES = 8 * HTB, NXCD = 8, WGM = 8;

__host__ __device__ __forceinline__ int lds_byte(int r, int c) { const int st = (r >> 4) * 2 + (c >> 5), rr = r & 15, cc = c & 31, ob = rr * 64 + cc * 2; return st * 1024 + (ob ^ (((ob >> 9) & 1) << 5)); }
__host__ __device__ __forceinline__ void stage_rc(int b, int& R, int& C) { const int st = b / 1024, sb = b % 1024, swz = sb ^ (((sb >> 9) & 1) << 5); R = (st >> 1) * 16 + swz / 64; C = (st & 1) * 32 + (swz % 64) / 2; }
__host__ __device__ __forceinline__ int perm32(int rho) { const int n = rho >> 4, i = rho & 15; return 8 * (i >> 2) + 4 * n + (i & 3); }

struct Unit { int pm, pn; };
struct Gemm { const bf16_t* A; const bf16_t* Bt; int M, N, K, lda, ldb; };

struct StaticOrder {
    int nM, nN, nwg, G, c;
    __host__ __device__ void init(int M, int N, int G_, int c_) { nM = M / BM; nN = N / BM; nwg = nM * nN; G = G_; c = c_; }
    __host__ __device__ bool next(int i, Unit& u) const {
        const long L = (long)i * G + c; if (L >= nwg) return false;
        int wgid = (int)L; { const int q = nwg / NXCD, r = nwg % NXCD, xcd = wgid % NXCD, off = wgid / NXCD; wgid = (xcd < r ? xcd * (q + 1) : r * (q + 1) + (xcd - r) * q) + off; }
        const int nig = WGM * nN, gid = wgid / nig, fm = gid * WGM, gsz = (nM - fm) < WGM ? (nM - fm) : WGM;
        u.pm = fm + ((wgid % nig) % gsz); u.pn = (wgid % nig) / gsz; return true;
    }
    __device__ __forceinline__ void a_ready(const Unit&) const {}
    __device__ __forceinline__ void done(const Unit&) const {}
};
__device__ __forceinline__ unsigned cvt_pk_bf16(float lo, float hi) { unsigned r; asm volatile("v_cvt_pk_bf16_f32 %0, %1, %2" : "=v"(r) : "v"(lo), "v"(hi)); return r; }
struct EpiF32 {
    static constexpr bool PERM = false, AFTER_DRAIN = false;
    float* C; int ldc; const float* bias;
    __device__ __forceinline__ void operator()(const f32x4 (&acc)[2][2][4][2], const Unit& u, int wr, int wc, int fr, int fq) const {
        const int row0 = u.pm * BM + wr * 64 + fr, col0 = u.pn * BM + wc * 32 + 4 * fq;
        f32x4 bv[2][2];
#pragma unroll
        for (int bj = 0; bj < 2; ++bj)
#pragma unroll
            for (int n = 0; n < 2; ++n) bv[bj][n] = bias ? *(const f32x4*)(bias + col0 + bj * HALF + n * 16) : (f32x4){0.f, 0.f, 0.f, 0.f};
#pragma unroll
        for (int ai = 0; ai < 2; ++ai)
#pragma unroll
            for (int m = 0; m < 4; ++m) { float* rowp = C + (size_t)(row0 + ai * HALF + m * 16) * ldc + col0;
#pragma unroll
                for (int bj = 0; bj < 2; ++bj)
#pragma unroll
                    for (int n = 0; n < 2; ++n) *(f32x4*)(rowp + bj * HALF + n * 16) = acc[ai][bj][m][n] + bv[bj][n]; }
    }
};
typedef unsigned u32x2 __attribute__((ext_vector_type(2)));
__device__ __forceinline__ float sigm(float x) { return __builtin_amdgcn_rcpf(1.0f + __expf(-x)); }
__device__ __forceinline__ float silu_f(float x) { return x * sigm(x); }
__device__ __forceinline__ float bf2f(unsigned short b) { return __uint_as_float(((unsigned)b) << 16); }
__device__ __forceinline__ float bflo(unsigned w) { return __uint_as_float(w << 16); }
__device__ __forceinline__ float bfhi(unsigned w) { return __uint_as_float(w & 0xffff0000u); }
struct EpiBf16P {
    static constexpr bool PERM = true, AFTER_DRAIN = false;
    bf16_t* O; int ldc;
    __device__ __forceinline__ void operator()(const f32x4 (&acc)[2][2][4][2], const Unit& u, int wr, int wc, int fr, int fq) const {
        const int row0 = u.pm * BM + wr * 64 + fr, col0 = u.pn * BM + wc * 32 + 8 * fq;
#pragma unroll
        for (int ai = 0; ai < 2; ++ai)
#pragma unroll
            for (int m = 0; m < 4; ++m) { bf16_t* rowp = O + (size_t)(row0 + ai * HALF + m * 16) * ldc + col0;
#pragma unroll
                for (int bj = 0; bj < 2; ++bj) { const f32x4 v0 = acc[ai][bj][m][0], v1 = acc[ai][bj][m][1];
                    u32x4 w; w.x = cvt_pk_bf16(v0[0], v0[1]); w.y = cvt_pk_bf16(v0[2], v0[3]); w.z = cvt_pk_bf16(v1[0], v1[1]); w.w = cvt_pk_bf16(v1[2], v1[3]);
                    *(u32x4*)(rowp + bj * HALF) = w; } }
    }
};
struct EpiSwiglu {
    static constexpr bool PERM = true, AFTER_DRAIN = false;
    bf16_t* O; int ldc;
    __device__ __forceinline__ void operator()(const f32x4 (&acc)[2][2][4][2], const Unit& u, int wr, int wc, int fr, int fq) const {
        const int row0 = u.pm * BM + wr * 64 + fr, col0 = u.pn * HALF + wc * 32 + 8 * fq;
#pragma unroll
        for (int ai = 0; ai < 2; ++ai)
#pragma unroll
            for (int m = 0; m < 4; ++m) { bf16_t* rowp = O + (size_t)(row0 + ai * HALF + m * 16) * ldc + col0;
                const f32x4 g0 = acc[ai][0][m][0], g1 = acc[ai][0][m][1], u0 = acc[ai][1][m][0], u1 = acc[ai][1][m][1];
                float r[8];
#pragma unroll
                for (int j = 0; j < 4; ++j) { r[j] = silu_f(g0[j]) * u0[j]; r[4 + j] = silu_f(g1[j]) * u1[j]; }
                u32x4 w; w.x = cvt_pk_bf16(r[0], r[1]); w.y = cvt_pk_bf16(r[2], r[3]); w.z = cvt_pk_bf16(r[4], r[5]); w.w = cvt_pk_bf16(r[6], r[7]);
                *(u32x4*)rowp = w; }
    }
};
struct EpiGate1 {
    static constexpr bool PERM = true, AFTER_DRAIN = false;
    bf16_t* C; int ldc; const bf16_t* G; int ldg;
    __device__ __forceinline__ void operator()(const f32x4 (&acc)[2][2][4][2], const Unit& u, int wr, int wc, int fr, int fq) const {
        const int row0 = u.pm * BM + wr * 64 + fr, col0 = u.pn * BM + wc * 32 + 8 * fq;
#pragma unroll
        for (int ai = 0; ai < 2; ++ai)
#pragma unroll
            for (int m = 0; m < 4; ++m) { const size_t row = (size_t)(row0 + ai * HALF + m * 16);
#pragma unroll
                for (int bj = 0; bj < 2; ++bj) { const int col = col0 + bj * HALF;
                    const u32x4 gw = *(const u32x4*)(G + row * ldg + col);
                    const f32x4 v0 = acc[ai][bj][m][0], v1 = acc[ai][bj][m][1];
                    u32x4 w; w.x = cvt_pk_bf16(sigm(bflo(gw.x)) * v0[0], sigm(bfhi(gw.x)) * v0[1]); w.y = cvt_pk_bf16(sigm(bflo(gw.y)) * v0[2], sigm(bfhi(gw.y)) * v0[3]);
                    w.z = cvt_pk_bf16(sigm(bflo(gw.z)) * v1[0], sigm(bfhi(gw.z)) * v1[1]); w.w = cvt_pk_bf16(sigm(bflo(gw.w)) * v1[2], sigm(bfhi(gw.w)) * v1[3]);
                    *(u32x4*)(C + row * ldc + col) = w; } }
    }
};
struct EpiGate2 {
    static constexpr bool PERM = true, AFTER_DRAIN = false;
    bf16_t* O; int ldc; const bf16_t* T1; const bf16_t* G; int ldg;
    __device__ __forceinline__ void operator()(const f32x4 (&acc)[2][2][4][2], const Unit& u, int wr, int wc, int fr, int fq) const {
        const int row0 = u.pm * BM + wr * 64 + fr, col0 = u.pn * BM + wc * 32 + 8 * fq;
#pragma unroll
        for (int ai = 0; ai < 2; ++ai)
#pragma unroll
            for (int m = 0; m < 4; ++m) { const size_t row = (size_t)(row0 + ai * HALF + m * 16);
#pragma unroll
                for (int bj = 0; bj < 2; ++bj) { const int col = col0 + bj * HALF;
                    const u32x4 gw = *(const u32x4*)(G + row * ldg + col);
                    const u32x4 tw = *(const u32x4*)(T1 + row * ldc + col);
                    const f32x4 t0 = {bflo(tw.x), bfhi(tw.x), bflo(tw.y), bfhi(tw.y)}, t1 = {bflo(tw.z), bfhi(tw.z), bflo(tw.w), bfhi(tw.w)};
                    const f32x4 v0 = acc[ai][bj][m][0], v1 = acc[ai][bj][m][1];
                    float r[8];
                    r[0] = t0[0] + sigm(bflo(gw.x)) * v0[0]; r[1] = t0[1] + sigm(bfhi(gw.x)) * v0[1]; r[2] = t0[2] + sigm(bflo(gw.y)) * v0[2]; r[3] = t0[3] + sigm(bfhi(gw.y)) * v0[3];
                    r[4] = t1[0] + sigm(bflo(gw.z)) * v1[0]; r[5] = t1[1] + sigm(bfhi(gw.z)) * v1[1]; r[6] = t1[2] + sigm(bflo(gw.w)) * v1[2]; r[7] = t1[3] + sigm(bfhi(gw.w)) * v1[3];
                    u32x4 w; w.x = cvt_pk_bf16(r[0], r[1]); w.y = cvt_pk_bf16(r[2], r[3]); w.z = cvt_pk_bf16(r[4], r[5]); w.w = cvt_pk_bf16(r[6], r[7]);
                    *(u32x4*)(O + row * ldc + col) = w; } }
    }
};
template <class Epi, class Sched, bool ALIGN_EPI = false, bool SP2 = false>
__device__ __forceinline__ void gemm_phase(PG8_LAS unsigned char* lds, const Gemm g, const Sched& S, const Epi& E) {
    int tid_ = threadIdx.x; asm volatile("" : "+v"(tid_));
    const int tid = tid_, wid = __builtin_amdgcn_readfirstlane(tid >> 6), lane = tid & 63, wr = wid >> 2, wc = wid & 3, fr = lane & 15, fq = lane >> 4;
    const int K = g.K, nt = K / BK;
    unsigned voffA[2], voffB[2];
#pragma unroll
    for (int i = 0; i < 2; ++i) { int R, C; stage_rc(tid * 16 + i * 8192, R, C); const int Rb = Epi::PERM ? ((R & ~31) + perm32(R & 31)) : R;
        voffA[i] = (unsigned)(R * g.lda + C) * 2u; voffB[i] = (unsigned)(Rb * g.ldb + C) * 2u; }
    const size_t kstep = (size_t)(BK * 2);
    const size_t hstepA = (size_t)HALF * g.lda * 2, hstepB = (size_t)HALF * g.ldb * 2;
    const size_t tstepA = 2 * hstepA, tstepB = 2 * hstepB;
    const unsigned ldsw = (unsigned)wid * 1024u;
    const int aoff = lds_byte(wr * 64 + fr, fq * 8), boff = lds_byte(wc * 32 + fr, fq * 8);
#define PG8_SA(b, h) (((b) * 2 + (h)) * HTB)
#define PG8_SB(b, h) ((4 + (b) * 2 + (h)) * HTB)
#define PG8_STAGE(bufoff, gbase, voff) do { _Pragma("unroll") for (int _i = 0; _i < 2; ++_i) \
        __builtin_amdgcn_global_load_lds((const unsigned*)((const char*)(gbase) + (voff)[_i]), (PG8_LAS unsigned*)(lds + (bufoff) + ldsw + _i * 8192), 16, 0, 0); } while (0)
#define PG8_LDA(dst, b, h) do { _Pragma("unroll") for (int m = 0; m < 4; ++m) _Pragma("unroll") for (int k = 0; k < 2; ++k) dst[m][k] = *(const PG8_LAS bf16x8*)(lds + PG8_SA(b, h) + aoff + m * 2048 + k * 1024); } while (0)
#define PG8_LDB(dst, b, h) do { _Pragma("unroll") for (int n = 0; n < 2; ++n) _Pragma("unroll") for (int k = 0; k < 2; ++k) dst[n][k] = *(const PG8_LAS bf16x8*)(lds + PG8_SB(b, h) + boff + n * 2048 + k * 1024); } while (0)
#define PG8_MMA(ai, bj, At, Bt) do { __builtin_amdgcn_s_setprio(1); _Pragma("unroll") for (int m = 0; m < 4; ++m) _Pragma("unroll") for (int n = 0; n < 2; ++n) _Pragma("unroll") for (int k = 0; k < 2; ++k) \
        acc[ai][bj][m][n] = __builtin_amdgcn_mfma_f32_16x16x32_bf16(Bt[n][k], At[m][k], acc[ai][bj][m][n], 0, 0, 0); __builtin_amdgcn_s_setprio(0); } while (0)
#define PG8_WAIT_V(n) asm volatile("s_waitcnt vmcnt(" #n ")" ::: "memory")
#define PG8_WAIT_L(n) asm volatile("s_waitcnt lgkmcnt(" #n ")" ::: "memory")
#define PG8_BAR __builtin_amdgcn_s_barrier()
#define PG8_SCHED __builtin_amdgcn_sched_barrier(0)
    Unit cur, nxt; int ui = 0;
    if (!S.next(0, cur)) return;
    f32x4 acc[2][2][4][2];
#pragma unroll
    for (int a = 0; a < 2; ++a)
#pragma unroll
        for (int b = 0; b < 2; ++b)
#pragma unroll
            for (int m = 0; m < 4; ++m)
#pragma unroll
                for (int n = 0; n < 2; ++n) acc[a][b][m][n] = (f32x4){0.f, 0.f, 0.f, 0.f};
    bf16x8 At[4][2], B0[2][2], B1[2][2];
    const char* cA = (const char*)g.A + (size_t)cur.pm * tstepA; const char* cB = (const char*)g.Bt + (size_t)cur.pn * tstepB;
    S.a_ready(cur);
    if constexpr (SP2) {
        PG8_STAGE(PG8_SB(0, 0), cB, voffB); PG8_STAGE(PG8_SB(0, 1), cB + hstepB, voffB); PG8_STAGE(PG8_SA(0, 0), cA, voffA); PG8_STAGE(PG8_SA(0, 1), cA + hstepA, voffA);
        if (wr == 1) PG8_BAR;
        PG8_WAIT_V(2); PG8_BAR;
        PG8_STAGE(PG8_SB(1, 0), cB + kstep, voffB); PG8_STAGE(PG8_SA(1, 0), cA + kstep, voffA); PG8_STAGE(PG8_SB(1, 1), cB + hstepB + kstep, voffB);
        PG8_WAIT_V(6); PG8_BAR;
    } else {
        PG8_STAGE(PG8_SB(0, 0), cB, voffB); PG8_STAGE(PG8_SA(0, 0), cA, voffA); PG8_STAGE(PG8_SB(0, 1), cB + hstepB, voffB); PG8_STAGE(PG8_SA(0, 1), cA + hstepA, voffA);
        if (wr == 1) PG8_BAR;
        PG8_WAIT_V(4); PG8_BAR;
        PG8_STAGE(PG8_SB(1, 0), cB + kstep, voffB); PG8_STAGE(PG8_SA(1, 0), cA + kstep, voffA); PG8_STAGE(PG8_SB(1, 1), cB + hstepB + kstep, voffB);
        PG8_WAIT_V(6); PG8_BAR;
    }
    for (;;) {
        const bool has_next = S.next(ui + 1, nxt);
        const char* nA = has_next ? (const char*)g.A + (size_t)nxt.pm * tstepA : cA; const char* nB = has_next ? (const char*)g.Bt + (size_t)nxt.pn * tstepB : cB;
        for (int t = 0; t < nt; t += 2) {
            const bool last = (t == nt - 2);
            const char* a1 = cA + (size_t)(t + 1) * kstep;
            const char* a2 = last ? nA : cA + (size_t)(t + 2) * kstep; const char* b2 = last ? nB : cB + (size_t)(t + 2) * kstep;
            const char* a3 = a2 + kstep; const char* b3 = b2 + kstep;
            if (last && has_next) S.a_ready(nxt);
            if constexpr (SP2) {
            PG8_LDB(B0, 0, 0); PG8_LDB(B1, 0, 1); PG8_SCHED; PG8_LDA(At, 0, 0); PG8_STAGE(PG8_SA(1, 1), a1 + hstepA, voffA);
            PG8_WAIT_V(8); PG8_WAIT_L(0); PG8_BAR; PG8_MMA(0, 0, At, B0); PG8_MMA(0, 1, At, B1); PG8_BAR; PG8_SCHED;
            PG8_LDA(At, 0, 1); PG8_STAGE(PG8_SB(0, 0), b2, voffB); PG8_STAGE(PG8_SB(0, 1), b2 + hstepB, voffB); PG8_STAGE(PG8_SA(0, 0), a2, voffA);
            PG8_WAIT_V(8); PG8_WAIT_L(0); PG8_BAR; PG8_MMA(1, 0, At, B0); PG8_MMA(1, 1, At, B1); PG8_BAR; PG8_SCHED;
            PG8_LDB(B0, 1, 0); PG8_LDB(B1, 1, 1); PG8_SCHED; PG8_LDA(At, 1, 0); PG8_STAGE(PG8_SA(0, 1), a2 + hstepA, voffA);
            PG8_WAIT_V(8); PG8_WAIT_L(0); PG8_BAR; PG8_MMA(0, 0, At, B0); PG8_MMA(0, 1, At, B1); PG8_BAR; PG8_SCHED;
            PG8_LDA(At, 1, 1); PG8_STAGE(PG8_SB(1, 0), b3, voffB); PG8_STAGE(PG8_SB(1, 1), b3 + hstepB, voffB); PG8_STAGE(PG8_SA(1, 0), a3, voffA);
            PG8_WAIT_V(8); PG8_WAIT_L(0); PG8_BAR; PG8_MMA(1, 0, At, B0); PG8_MMA(1, 1, At, B1); PG8_BAR; PG8_SCHED;
            } else {
            PG8_LDB(B0, 0, 0); PG8_SCHED; PG8_LDA(At, 0, 0); PG8_STAGE(PG8_SA(1, 1), a1 + hstepA, voffA);
            PG8_WAIT_L(8); PG8_BAR; PG8_WAIT_L(0); PG8_MMA(0, 0, At, B0); PG8_BAR; PG8_SCHED;
            PG8_LDB(B1, 0, 1); PG8_STAGE(PG8_SB(0, 0), b2, voffB);
            PG8_BAR; PG8_WAIT_L(0); PG8_MMA(0, 1, At, B1); PG8_BAR;
            PG8_LDA(At, 0, 1); PG8_STAGE(PG8_SA(0, 0), a2, voffA);
            PG8_BAR; PG8_WAIT_L(0); PG8_MMA(1, 0, At, B0); PG8_BAR; PG8_SCHED;
            PG8_STAGE(PG8_SB(0, 1), b2 + hstepB, voffB);
            PG8_WAIT_V(6); PG8_BAR; PG8_MMA(1, 1, At, B1); PG8_BAR;
            PG8_LDB(B0, 1, 0); PG8_SCHED; PG8_LDA(At, 1, 0); PG8_STAGE(PG8_SA(0, 1), a2 + hstepA, voffA);
            PG8_WAIT_L(8); PG8_BAR; PG8_WAIT_L(0); PG8_MMA(0, 0, At, B0); PG8_BAR; PG8_SCHED;
            PG8_LDB(B1, 1, 1); PG8_STAGE(PG8_SB(1, 0), b3, voffB);
            PG8_BAR; PG8_WAIT_L(0); PG8_MMA(0, 1, At, B1); PG8_BAR;
            PG8_LDA(At, 1, 1); PG8_STAGE(PG8_SA(1, 0), a3, voffA);
            PG8_BAR; PG8_WAIT_L(0); PG8_MMA(1, 0, At, B0); PG8_BAR; PG8_SCHED;
            PG8_STAGE(PG8_SB(1, 1), b3 + hstepB, voffB);
            PG8_WAIT_V(6); PG8_BAR; PG8_MMA(1, 1, At, B1); PG8_BAR;
            }
        }
        if constexpr (ALIGN_EPI) { if (wr == 0) PG8_BAR; }
        if constexpr (!Epi::AFTER_DRAIN) { E(acc, cur, wr, wc, fr, fq); S.done(cur); }
        if (!has_next) break;
#pragma unroll
        for (int a = 0; a < 2; ++a)
#pragma unroll
            for (int b = 0; b < 2; ++b)
#pragma unroll
                for (int m = 0; m < 4; ++m)
#pragma unroll
                    for (int n = 0; n < 2; ++n) acc[a][b][m][n] = (f32x4){0.f, 0.f, 0.f, 0.f};
        cur = nxt; cA = nA; cB = nB; ++ui;
        if constexpr (ALIGN_EPI) { if (wr == 1) PG8_BAR; }
    }
    PG8_WAIT_V(0);
    if constexpr (!ALIGN_EPI) { if (wr == 0) PG8_BAR; }
    PG8_BAR;
    if constexpr (Epi::AFTER_DRAIN) { E.fused(acc, cur, wr, wc, fr, fq, lds, wid, lane); S.done(cur); }
#undef PG8_SA
#undef PG8_SB
#undef PG8_STAGE
#undef PG8_LDA
#undef PG8_LDB
#undef PG8_MMA
#undef PG8_WAIT_V
#undef PG8_WAIT_L
#undef PG8_BAR
#undef PG8_SCHED
}
}

using pg8::bf16_t; using pg8::bf16x8; using pg8::f32x4; using pg8::u32x4; using pg8::u32x2;
using pg8::sigm; using pg8::silu_f; using pg8::bf2f; using pg8::bflo; using pg8::bfhi;
#define LAS __attribute__((address_space(3)))
#define DI __device__ __forceinline__
typedef short s16x4 __attribute__((ext_vector_type(4)));
typedef float f32x2 __attribute__((ext_vector_type(2)));
typedef __bf16 bf2v __attribute__((ext_vector_type(2)));

constexpr int D = 2048, DFF = 5632, MT = 8704, MPR = 8192, DINP = 10496;
constexpr int C_Z = 3072, C_B = 4096, C_A = 4104, C_QM = 4112, C_CKV = 5648, C_KR = 6160, C_GG = 6224, C_GM = 8272;
constexpr size_t O_CONVP = 17825792, O_SSMP = 17844224, O_CKVP = 18106368, O_KRP = 22300672, O_CONVS = 22824960, O_SSMS = 22972416, O_CKVS = 25069568, O_KRS = 25331712;
constexpr size_t OFF_WIN = 0, OFF_WBRG = 42991616, OFF_WBRM = 47185920, OFF_WOUT = 51380224, OFF_WUK = 59768832, OFF_WUV = 60817408,
                 OFF_WGU = 61865984, OFF_WD = 108003328, OFF_XN = 131072000, OFF_QP = OFF_XN, OFF_CKVB = OFF_XN + 25165824, OFF_KRB = OFF_XN + 34078720,
                 OFF_R1 = 166723584, OFF_F = 349437952, OFF_GO = OFF_F, OFF_PO = OFF_F + 35651584, OFF_KV = 420741120, OFF_OM = 454295552, OFF_OG = 472121344,
                 OFF_QS = 489947136, OFF_ML = 494665728, OFF_CTL = 494796800, OFF_GP = 494800896, GP_STRIDE = 90368, WS_END = OFF_GP + 1152 * GP_STRIDE, OFF_BAR = WS_END, OFF_KCR = WS_END + 16384, OFF_KCC = OFF_WGU, WS_TOTAL = OFF_KCR + 8388608;
constexpr int LDS_BYTES = 155648, LDS_CTL = 155392;
constexpr float QSCALE = 0.10411754f;
constexpr float NEPS = 1e-6f;

struct Params { const float* in[29]; float* out; unsigned char* ws; };

DI unsigned pk2(float lo, float hi) { f32x2 v = {lo, hi}; bf2v b = __builtin_convertvector(v, bf2v); return __builtin_bit_cast(unsigned, b); }
DI unsigned short f2bf(float f) { __bf16 b = (__bf16)f; return __builtin_bit_cast(unsigned short, b); }
DI float wave_sum(float v) {
#pragma unroll
    for (int o = 32; o; o >>= 1) v += __shfl_xor(v, o);
    return v; }
DI f32x4 mfma16(bf16x8 a, bf16x8 b, f32x4 c) { return __builtin_amdgcn_mfma_f32_16x16x32_bf16(a, b, c, 0, 0, 0); }
DI s16x4 tr_read(const LAS bf16_t* p) { return __builtin_amdgcn_ds_read_tr16_b64_v4i16((LAS s16x4*)p); }
DI void unpack8(u32x4 w, float* x) { x[0] = bflo(w.x); x[1] = bfhi(w.x); x[2] = bflo(w.y); x[3] = bfhi(w.y); x[4] = bflo(w.z); x[5] = bfhi(w.z); x[6] = bflo(w.w); x[7] = bfhi(w.w); }
DI u32x4 pack8(const float* x) { u32x4 w; w.x = pk2(x[0], x[1]); w.y = pk2(x[2], x[3]); w.z = pk2(x[4], x[5]); w.w = pk2(x[6], x[7]); return w; }

struct TJ { const float* src; bf16_t* dst; int K, N, ldd, mode; };
template <class JOBFN>
DI void transpose_pass4(LAS float* tiles, const Params& p, int t0, JOBFN jobfn, int tid, bool& any) {
    TJ j[4]; int tk[4], tn[4]; bool ok[4];
#pragma unroll
    for (int u = 0; u < 4; ++u) ok[u] = jobfn(p, t0 + u, j[u], tk[u], tn[u]);
    any = ok[0];
    if (!any) return;
    const int r = tid >> 4, c4 = (tid & 15) * 4;
    float4 v0[4], v1[4];
#pragma unroll
    for (int u = 0; u < 4; ++u) { v0[u] = make_float4(0.f, 0.f, 0.f, 0.f); v1[u] = v0[u];
      if (ok[u] && tn[u] * 64 + c4 < j[u].N) { const float* s = j[u].src + (size_t)(tk[u] * 64 + r) * j[u].N + tn[u] * 64 + c4; const f32x4 t0 = __builtin_nontemporal_load((const f32x4*)s), t1 = __builtin_nontemporal_load((const f32x4*)(s + (size_t)32 * j[u].N)); v0[u] = make_float4(t0[0], t0[1], t0[2], t0[3]); v1[u] = make_float4(t1[0], t1[1], t1[2], t1[3]); } }
#pragma unroll
    for (int u = 0; u < 4; ++u) { LAS float* t0p = tiles + u * 4160 + r * 65 + c4; t0p[0] = v0[u].x; t0p[1] = v0[u].y; t0p[2] = v0[u].z; t0p[3] = v0[u].w;
      LAS float* t1p = t0p + 32 * 65; t1p[0] = v1[u].x; t1p[1] = v1[u].y; t1p[2] = v1[u].z; t1p[3] = v1[u].w; }
    __syncthreads();
    const int n = tid >> 3, k8 = (tid & 7) * 8;
#pragma unroll
    for (int u = 0; u < 4; ++u) { const int gn = tn[u] * 64 + n;
      if (ok[u] && gn < j[u].N) { float e[8];
#pragma unroll
        for (int q = 0; q < 8; ++q) e[q] = tiles[u * 4160 + (k8 + q) * 65 + n];
        const int drow = j[u].mode == 0 ? gn : ((gn >> 7) * 256 + (gn & 127) + (j[u].mode == 2 ? 128 : 0));
        *(u32x4*)(j[u].dst + (size_t)drow * j[u].ldd + tk[u] * 64 + k8) = pack8(e); } }
    __syncthreads();
}
#define TJOB(SRC, DST, K_, N_, MODE) { const int ntn = ((N_) + 63) / 64, nt = ((K_) / 64) * ntn; if (t < nt) { j.src = (SRC); j.dst = (bf16_t*)(DST); j.K = (K_); j.N = (N_); j.ldd = (K_); j.mode = (MODE); tk = t / ntn; tn = t % ntn; return true; } t -= nt; }
DI bool tjob_p0(const Params& p, int t, TJ& j, int& tk, int& tn) {
    unsigned char* ws = p.ws;
    TJOB(p.in[7], ws + OFF_WGU, 2048, 5632, 1)
    TJOB(p.in[8], ws + OFF_WGU, 2048, 5632, 2)
    TJOB(p.in[9], ws + OFF_WD, 5632, 2048, 0)
    return false;
}
DI bool tjob_win(const Params& p, int t, TJ& j, int& tk, int& tn) {
    unsigned char* ws = p.ws;
    TJOB(p.in[12], ws + OFF_WIN, 2048, 10320, 0)
    return false;
}
DI bool tjob_late(const Params& p, int t, TJ& j, int& tk, int& tn) {
    unsigned char* ws = p.ws;
    TJOB(p.in[18], ws + OFF_WUK, 512, 1024, 0)
    TJOB(p.in[19], ws + OFF_WUV, 512, 1024, 0)
    TJOB(p.in[20], ws + OFF_WBRG, 1024, 2048, 0)
    TJOB(p.in[21], ws + OFF_WBRM, 1024, 2048, 0)
    TJOB(p.in[22], ws + OFF_WOUT, 2048, 2048, 0)
    return false;
}
DI bool tjob_p3(const Params& p, int t, TJ& j, int& tk, int& tn) {
    unsigned char* ws = p.ws;
    TJOB(p.in[25], ws + OFF_WGU, 2048, 5632, 1)
    TJOB(p.in[26], ws + OFF_WGU, 2048, 5632, 2)
    TJOB(p.in[27], ws + OFF_WD, 5632, 2048, 0)
    return false;
}

template <bool HAS_F, bool W_Y, bool W_XN, bool RB = false, bool YB = false>
DI void rowop(const float* resid, const float* f, const bf16_t* fb, int nsum, float alpha, const float* gpost, const float* gnext, float* y, bf16_t* xn, int lane, const bf16_t* residb = nullptr, bf16_t* yb = nullptr) {
    float4 v[8];
#pragma unroll
    for (int i = 0; i < 8; ++i) { if (RB) { const u32x2 t = __builtin_nontemporal_load((const u32x2*)(residb + (i * 64 + lane) * 4)); v[i] = make_float4(bflo(t.x), bfhi(t.x), bflo(t.y), bfhi(t.y)); }
      else if (HAS_F) { const f32x4 t = __builtin_nontemporal_load((const f32x4*)(resid + (i * 64 + lane) * 4)); v[i] = make_float4(t[0], t[1], t[2], t[3]); }
      else v[i] = *(const float4*)(resid + (i * 64 + lane) * 4); }
    if (HAS_F) {
        float4 fv[8]; float ss = 0.f;
        { const bf16_t* f0 = fb ? fb : (const bf16_t*)f;
#pragma unroll
          for (int i = 0; i < 8; ++i) { const u32x2 t = __builtin_nontemporal_load((const u32x2*)(f0 + (i * 64 + lane) * 4)); fv[i] = make_float4(bflo(t.x), bfhi(t.x), bflo(t.y), bfhi(t.y)); } }
#pragma unroll 1
        for (int s = 1; s < nsum; ++s) {
#pragma unroll
          for (int i = 0; i < 8; ++i) { const u32x2 t = __builtin_nontemporal_load((const u32x2*)((const bf16_t*)f + (size_t)s * 512 * 2048 + (i * 64 + lane) * 4)); fv[i].x += bflo(t.x); fv[i].y += bfhi(t.x); fv[i].z += bflo(t.y); fv[i].w += bfhi(t.y); } }
#pragma unroll
        for (int i = 0; i < 8; ++i) ss += fv[i].x * fv[i].x + fv[i].y * fv[i].y + fv[i].z * fv[i].z + fv[i].w * fv[i].w;
        ss = wave_sum(ss); const float rs = rsqrtf(ss * (1.0f / 2048.0f) + NEPS) * alpha;
#pragma unroll
        for (int i = 0; i < 8; ++i) { const float4 g = *(const float4*)(gpost + (i * 64 + lane) * 4);
            v[i].x += fv[i].x * rs * g.x; v[i].y += fv[i].y * rs * g.y; v[i].z += fv[i].z * rs * g.z; v[i].w += fv[i].w * rs * g.w; }
    }
    if (W_Y) {
#pragma unroll
        for (int i = 0; i < 8; ++i) { if (YB) { u32x2 w; w.x = pk2(v[i].x, v[i].y); w.y = pk2(v[i].z, v[i].w); *(u32x2*)(yb + (i * 64 + lane) * 4) = w; } else __builtin_nontemporal_store((f32x4){v[i].x, v[i].y, v[i].z, v[i].w}, (f32x4*)(y + (i * 64 + lane) * 4)); }
    }
    if (W_XN) {
        float ss = 0.f;
#pragma unroll
        for (int i = 0; i < 8; ++i) ss += v[i].x * v[i].x + v[i].y * v[i].y + v[i].z * v[i].z + v[i].w * v[i].w;
        ss = wave_sum(ss); const float rs = rsqrtf(ss * (1.0f / 2048.0f) + NEPS);
#pragma unroll
        for (int i = 0; i < 8; ++i) { const float4 g = *(const float4*)(gnext + (i * 64 + lane) * 4);
            u32x2 w; w.x = pk2(v[i].x * rs * g.x, v[i].y * rs * g.y); w.y = pk2(v[i].z * rs * g.z, v[i].w * rs * g.w);
            *(u32x2*)(xn + (i * 64 + lane) * 4) = w; }
    }
}
DI const float* xin_row(const Params& p, int r) { return r < MPR ? p.in[0] + (size_t)r * D : p.in[1] + (size_t)(r - MPR) * D; }

DI void mla_prep_row(const Params& p, int r, int lane) {
    unsigned char* ws = p.ws;
    const bf16_t* pr = (const bf16_t*)(ws + OFF_R1) + (size_t)r * DINP;
    const bool samp = r >= MPR; const int rs = r - MPR; const int pos = samp ? 4096 + (rs & 31) : (r & 4095);
    { float x[8]; unpack8(*(const u32x4*)(pr + C_CKV + lane * 8), x);
      float ss = 0.f;
#pragma unroll
      for (int i = 0; i < 8; ++i) ss += x[i] * x[i];
      ss = wave_sum(ss); const float rn = rsqrtf(ss * (1.0f / 512.0f) + NEPS);
      const float4 g0 = *(const float4*)(p.in[17] + lane * 8), g1 = *(const float4*)(p.in[17] + lane * 8 + 4);
      x[0] *= rn * g0.x; x[1] *= rn * g0.y; x[2] *= rn * g0.z; x[3] *= rn * g0.w; x[4] *= rn * g1.x; x[5] *= rn * g1.y; x[6] *= rn * g1.z; x[7] *= rn * g1.w;
      float* o = p.out + (samp ? O_CKVS + (size_t)rs * 512 : O_CKVP + (size_t)r * 512) + lane * 8;
      *(float4*)o = make_float4(x[0], x[1], x[2], x[3]); *(float4*)(o + 4) = make_float4(x[4], x[5], x[6], x[7]);
      *(u32x4*)((bf16_t*)(ws + OFF_CKVB) + (size_t)r * 512 + lane * 8) = pack8(x); }
    const int i = lane & 31;
    const float inv = exp2f(-(float)i * 0.41524101186f); float rev = (float)pos * inv * 0.15915494309f; rev -= floorf(rev);
    const float sn = __builtin_amdgcn_sinf(rev), cs = __builtin_amdgcn_cosf(rev);
    if (lane < 32) { const float x1 = bf2f(pr[C_KR + i]), x2 = bf2f(pr[C_KR + 32 + i]);
      const float o1 = x1 * cs - x2 * sn, o2 = x2 * cs + x1 * sn;
      float* o = p.out + (samp ? O_KRS + (size_t)rs * 64 : O_KRP + (size_t)r * 64);
      o[i] = o1; o[32 + i] = o2;
      bf16_t* kb = (bf16_t*)(ws + OFF_KRB) + (size_t)r * 64; kb[i] = f2bf(o1); kb[32 + i] = f2bf(o2); }
#pragma unroll
    for (int hh = 0; hh < 4; ++hh) { const int h = hh * 2 + (lane >> 5);
      const float x1 = bf2f(pr[C_QM + h * 192 + 128 + i]), x2 = bf2f(pr[C_QM + h * 192 + 160 + i]);
      const float o1 = (x1 * cs - x2 * sn) * QSCALE, o2 = (x2 * cs + x1 * sn) * QSCALE;
      bf16_t* q = samp ? (bf16_t*)(ws + OFF_QS) + ((size_t)(((rs >> 5) * 8 + h) * 32 + (rs & 31))) * 576 + 512
                       : (bf16_t*)(ws + OFF_QP) + ((size_t)r * 8 + h) * 192 + 128;
      q[i] = f2bf(o1); q[32 + i] = f2bf(o2); }
    if (!samp) {
#pragma unroll
      for (int it = 0; it < 2; ++it) { const int idx = it * 512 + lane * 8, h = idx >> 7, d = idx & 127;
        float x[8]; unpack8(*(const u32x4*)(pr + C_QM + h * 192 + d), x);
#pragma unroll
        for (int q = 0; q < 8; ++q) x[q] *= QSCALE;
        *(u32x4*)((bf16_t*)(ws + OFF_QP) + ((size_t)r * 8 + h) * 192 + d) = pack8(x); } }
}

DI void qlat_item(const Params& p, int b, int h, int tid) {
    unsigned char* ws = p.ws;
    const int w = tid >> 6, lane = tid & 63, g = lane >> 4, c16 = lane & 15;
    bf16x8 qa[2][4];
#pragma unroll
    for (int mt = 0; mt < 2; ++mt)
#pragma unroll
      for (int ks = 0; ks < 4; ++ks) qa[mt][ks] = *(const bf16x8*)((const bf16_t*)(ws + OFF_R1) + (size_t)(MPR + b * 32 + 16 * mt + c16) * DINP + C_QM + h * 192 + 32 * ks + 8 * g);
    bf16_t* qo = (bf16_t*)(ws + OFF_QS) + (size_t)((b * 8 + h) * 32) * 576;
#pragma unroll
    for (int n4 = 0; n4 < 4; ++n4) { const int c = 16 * (4 * w + n4) + c16;
      const float* wp = p.in[18] + (size_t)c * 1024 + h * 128 + 8 * g;
      float4 wl[4][2];
#pragma unroll
      for (int ks = 0; ks < 4; ++ks) { wl[ks][0] = *(const float4*)(wp + 32 * ks); wl[ks][1] = *(const float4*)(wp + 32 * ks + 4); }
      f32x4 acc[2] = {(f32x4){0.f, 0.f, 0.f, 0.f}, (f32x4){0.f, 0.f, 0.f, 0.f}};
#pragma unroll
      for (int ks = 0; ks < 4; ++ks) { u32x4 pw; pw.x = pk2(wl[ks][0].x, wl[ks][0].y); pw.y = pk2(wl[ks][0].z, wl[ks][0].w); pw.z = pk2(wl[ks][1].x, wl[ks][1].y); pw.w = pk2(wl[ks][1].z, wl[ks][1].w);
        const bf16x8 wb = __builtin_bit_cast(bf16x8, pw);
#pragma unroll
        for (int mt = 0; mt < 2; ++mt) acc[mt] = mfma16(qa[mt][ks], wb, acc[mt]); }
#pragma unroll
      for (int mt = 0; mt < 2; ++mt)
#pragma unroll
        for (int j = 0; j < 4; ++j) qo[(size_t)(16 * mt + 4 * g + j) * 576 + c] = f2bf(acc[mt][j] * QSCALE); }
}
#define XB_TMO      128
#define XB_XCNT(j)  (256  + 64 * (j))
#define XB_XSUB(j)  (1280 + 64 * (j))
#define XB_XGEN(j)  (2304 + 64 * (j))
#define XB_TOP      3328
#define XB_TOPGEN   3392
#define XCD_BAR_WORDS 3456
#define XB_SPIN_CAP (1u << 18)

__device__ __forceinline__ unsigned xb_ld(unsigned* p)              { return __hip_atomic_load(p, __ATOMIC_RELAXED, __HIP_MEMORY_SCOPE_AGENT); }
__device__ __forceinline__ unsigned xb_add(unsigned* p, unsigned v) { return __hip_atomic_fetch_add(p, v, __ATOMIC_RELAXED, __HIP_MEMORY_SCOPE_AGENT); }
__device__ __forceinline__ unsigned xb_xcc_id() { return (unsigned)__builtin_amdgcn_s_getreg((3 << 11) | 20) & 0xFu; }
#define XB_SPIN(cond, bar) do { unsigned _sp = 0; while (cond) { __builtin_amdgcn_s_sleep(1); \
    if ((++_sp & 255u) == 0u) { if (xb_ld(&(bar)[XB_TMO])) break; if (_sp > XB_SPIN_CAP) { atomicAdd(&(bar)[XB_TMO], 1u); break; } } } } while (0)

struct XcdBarrier {
    unsigned* bar; unsigned x;
    volatile LAS unsigned* st;
};

__device__ __forceinline__ XcdBarrier xcd_barrier_post(unsigned* bar, volatile LAS unsigned* st) {
    XcdBarrier b; b.bar = bar; b.x = xb_xcc_id(); b.st = st;
    if (threadIdx.x == 0) (void)xb_add(&bar[XB_XCNT(b.x)], 1u);
    return b;
}
__device__ __forceinline__ void xcd_barrier_complete(unsigned* bar, unsigned x, unsigned& nloc, unsigned& nx) {
    const unsigned G = gridDim.x * gridDim.y * gridDim.z;
    unsigned sum, cnt, mine, sp = 0u;
    for (;;) {
        sum = 0u; cnt = 0u; mine = 0u;
#pragma unroll
        for (unsigned j = 0; j < 16; ++j) { const unsigned c = xb_ld(&bar[XB_XCNT(j)]); sum += c; cnt += (c > 0u) ? 1u : 0u; mine = (j == x) ? c : mine; }
        if (sum == G) break;
        __builtin_amdgcn_s_sleep(1);
        if ((++sp & 255u) == 0u) { if (xb_ld(&bar[XB_TMO])) break; if (sp > XB_SPIN_CAP) { atomicAdd(&bar[XB_TMO], 1u); break; } }
    }
    nloc = mine > 0u ? mine : 1u; nx = cnt > 0u ? cnt : 1u;
}

__device__ __forceinline__ void xcd_barrier(const XcdBarrier& b) {
    asm volatile("s_waitcnt vmcnt(0)" ::: "memory");
    __syncthreads();
    if (threadIdx.x == 0) {
        unsigned* bar = b.bar;
        __builtin_amdgcn_s_waitcnt(0);
        unsigned nloc = b.st[0], nx = b.st[1];
        if (nloc == 0u) { xcd_barrier_complete(bar, b.x, nloc, nx); b.st[0] = nloc; b.st[1] = nx; }
        const unsigned old = xb_add(&bar[XB_XSUB(b.x)], 1u);
        const unsigned gen = old / nloc;
        if (old + 1u == (gen + 1u) * nloc) {
            __builtin_amdgcn_fence(__ATOMIC_RELEASE, "agent");
            asm volatile("s_waitcnt vmcnt(0)" ::: "memory");
            const unsigned og = xb_add(&bar[XB_TOP], 1u);
            const unsigned tg = og / nx;
            if (og + 1u == (tg + 1u) * nx) xb_add(&bar[XB_TOPGEN], 1u);
            else XB_SPIN(xb_ld(&bar[XB_TOPGEN]) == tg, bar);
            __builtin_amdgcn_fence(__ATOMIC_ACQUIRE, "agent");
            xb_add(&bar[XB_XGEN(b.x)], 1u);
            asm volatile("s_waitcnt vmcnt(0)" ::: "memory");
        } else {
            XB_SPIN(xb_ld(&bar[XB_XGEN(b.x)]) == gen, bar);
            __builtin_amdgcn_fence(__ATOMIC_ACQUIRE, "agent");
            asm volatile("s_waitcnt vmcnt(0)" ::: "memory");
        }
    }
    __syncthreads();
}

DI void gdn_prep_item(const Params& p, int item, LAS unsigned char* lds, int tid) {
    unsigned char* ws = p.ws;
    int seq, ch, h; if (item < 1024) { seq = item >> 9; ch = (item >> 3) & 63; h = item & 7; } else { const int x = item - 1024; seq = 2 + (x >> 3); ch = 0; h = x & 7; }
    const bool samp = seq >= 2; const int ntok = samp ? 32 : 64;
    const int r0 = samp ? MPR + (seq - 2) * 32 : seq * 4096 + ch * 64;
    const bf16_t* proj = (const bf16_t*)(ws + OFF_R1);
    LAS bf16_t* sqb = (LAS bf16_t*)lds; LAS bf16_t* skb = sqb + 64 * 136;
    LAS float* sk = (LAS float*)(lds + 2 * 64 * 136 * 2); LAS float* sv = sk + 64 * 132; LAS float* sA = sv + 64 * 132;
    LAS float* s_gc = sA + 64 * 68; LAS float* s_beta = s_gc + 64; LAS float* s_eg = s_beta + 64; LAS float* sW = s_eg + 64;
    unsigned char* gp = ws + OFF_GP + (size_t)item * GP_STRIDE;
    { const int i = tid >> 3, dg = tid & 7;
#pragma unroll
      for (int which = 0; which < 3; ++which) { const int col = which * 1024 + h * 128 + dg * 16;
        float y[16];
#pragma unroll
        for (int c = 0; c < 16; ++c) y[c] = 0.f;
        if (i < ntok) {
#pragma unroll
          for (int jt = 0; jt < 4; ++jt) { const int tt = i - 3 + jt; float x[16];
            if (ch * 64 + tt >= 0) { const bf16_t* s = proj + (size_t)(r0 + tt) * DINP + col; unpack8(*(const u32x4*)s, x); unpack8(*(const u32x4*)(s + 8), x + 8); }
            else if (samp) { const float* s = p.in[2] + (size_t)((seq - 2) * 3 + 3 + tt) * 3072 + col;
#pragma unroll
              for (int c4 = 0; c4 < 4; ++c4) { const float4 v = *(const float4*)(s + c4 * 4); x[c4 * 4] = v.x; x[c4 * 4 + 1] = v.y; x[c4 * 4 + 2] = v.z; x[c4 * 4 + 3] = v.w; } }
            else {
#pragma unroll
              for (int c = 0; c < 16; ++c) x[c] = 0.f; }
            const float* wp = p.in[13] + jt * 3072 + col;
#pragma unroll
            for (int c4 = 0; c4 < 4; ++c4) { const float4 wv = *(const float4*)(wp + c4 * 4);
              y[c4 * 4] += x[c4 * 4] * wv.x; y[c4 * 4 + 1] += x[c4 * 4 + 1] * wv.y; y[c4 * 4 + 2] += x[c4 * 4 + 2] * wv.z; y[c4 * 4 + 3] += x[c4 * 4 + 3] * wv.w; } }
#pragma unroll
          for (int c = 0; c < 16; ++c) y[c] = silu_f(y[c]);
        }
        if (which < 2) { float ss = 0.f;
#pragma unroll
          for (int c = 0; c < 16; ++c) ss += y[c] * y[c];
          ss += __shfl_xor(ss, 1); ss += __shfl_xor(ss, 2); ss += __shfl_xor(ss, 4);
          const float sc = rsqrtf(ss + 1e-6f) * (which == 0 ? 0.08838834764f : 1.0f);
#pragma unroll
          for (int c = 0; c < 16; ++c) y[c] *= sc; }
        if (which > 0) { LAS float* dst = (which == 1 ? sk : sv) + i * 132 + dg * 16;
#pragma unroll
          for (int c4 = 0; c4 < 4; ++c4) *(LAS f32x4*)(dst + c4 * 4) = (f32x4){y[c4 * 4], y[c4 * 4 + 1], y[c4 * 4 + 2], y[c4 * 4 + 3]}; }
        if (which < 2) { LAS bf16_t* db = (which == 0 ? sqb : skb) + i * 136 + dg * 16; *(LAS u32x4*)db = pack8(y); *(LAS u32x4*)(db + 8) = pack8(y + 8); } } }
    if (tid < 64) { float g = 0.f, beta = 0.f;
      if (tid < ntok) { const bf16_t* s = proj + (size_t)(r0 + tid) * DINP; const float braw = bf2f(s[C_B + h]), araw = bf2f(s[C_A + h]);
        beta = 1.0f / (1.0f + expf(-braw)); const float xx = araw + p.in[15][h]; const float sp = xx > 20.f ? xx : log1pf(expf(xx)); g = -expf(p.in[14][h]) * sp; }
      float gc = g;
#pragma unroll
      for (int o = 1; o < 64; o <<= 1) { const float n = __shfl_up(gc, o); if (tid >= o) gc += n; }
      s_gc[tid] = gc; s_beta[tid] = beta; s_eg[tid] = expf(gc); }
    __syncthreads();
    { const int w = tid >> 6, lane = tid & 63, g = lane >> 4, c16 = lane & 15;
      bf16_t* QKo = (bf16_t*)(gp + 81920);
#pragma unroll 1
      for (int jb = 0; jb < 4; ++jb) { const int job = w * 4 + jb, tile = job >> 1, type = job & 1, mt = tile >> 2, nt = tile & 3;
        f32x4 acc = {0.f, 0.f, 0.f, 0.f};
        if (mt >= nt) { const LAS bf16_t* ap = (type ? sqb : skb) + (16 * mt + c16) * 136 + 8 * g; const LAS bf16_t* bp = skb + (16 * nt + c16) * 136 + 8 * g;
#pragma unroll
          for (int ks = 0; ks < 4; ++ks) acc = mfma16(*(const LAS bf16x8*)(ap + 32 * ks), *(const LAS bf16x8*)(bp + 32 * ks), acc); }
        const int j = 16 * nt + c16; const float gj = s_gc[j];
#pragma unroll
        for (int jj = 0; jj < 4; ++jj) { const int i = 16 * mt + 4 * g + jj; const float dec = (i >= j) ? expf(s_gc[i] - gj) : 0.f;
          if (type == 0) sA[i * 68 + j] = (i > j) ? s_beta[i] * acc[jj] * dec : 0.f;
          else QKo[i * 64 + j] = f2bf(acc[jj] * dec); } } }
    __syncthreads();
    if (tid >= 256) { const int t2 = tid - 256; const float glast = s_gc[63];
      { const int i = t2 >> 2, d0 = (t2 & 3) * 32; const float e = s_eg[i];
#pragma unroll
        for (int c8 = 0; c8 < 4; ++c8) { float x[8];
          unpack8(*(const LAS u32x4*)(sqb + i * 136 + d0 + c8 * 8), x);
#pragma unroll
          for (int q = 0; q < 8; ++q) x[q] *= e;
          *(u32x4*)((bf16_t*)(gp + 49152) + i * 128 + d0 + c8 * 8) = pack8(x); } }
      { const int d = t2 >> 1, i0 = (t2 & 1) * 32;
#pragma unroll
        for (int c8 = 0; c8 < 4; ++c8) { float x[8];
#pragma unroll
          for (int q = 0; q < 8; ++q) { const int i = i0 + c8 * 8 + q; x[q] = sk[i * 132 + d] * expf(glast - s_gc[i]); }
          *(u32x4*)((bf16_t*)(gp + 65536) + d * 64 + i0 + c8 * 8) = pack8(x); } }
      if (t2 == 0) *(float*)(gp + 90112) = expf(glast); }
    else { const bool isW = tid >= 128; const int d = tid & 127; const LAS float* Xs = isW ? sk : sv; LAS float* X = isW ? sW : sv;
#pragma unroll 1
      for (int ib = 0; ib < (samp ? 4 : 8); ++ib) { float s[8];
#pragma unroll
        for (int r = 0; r < 8; ++r) { const int i = 8 * ib + r; s[r] = Xs[i * 132 + d] * s_beta[i] * (isW ? s_eg[i] : 1.0f); }
#pragma unroll 2
        for (int j4 = 0; j4 < 2 * ib; ++j4) { const float x0 = X[(4 * j4) * 132 + d], x1 = X[(4 * j4 + 1) * 132 + d], x2 = X[(4 * j4 + 2) * 132 + d], x3 = X[(4 * j4 + 3) * 132 + d];
#pragma unroll
          for (int r = 0; r < 8; ++r) { const f32x4 a = *(const LAS f32x4*)(sA + (8 * ib + r) * 68 + 4 * j4); s[r] -= a[0] * x0 + a[1] * x1 + a[2] * x2 + a[3] * x3; } }
#pragma unroll
        for (int r = 1; r < 8; ++r)
#pragma unroll
          for (int c = 0; c < r; ++c) s[r] -= sA[(8 * ib + r) * 68 + 8 * ib + c] * s[c];
#pragma unroll
        for (int r = 0; r < 8; ++r) X[(8 * ib + r) * 132 + d] = s[r]; }
      if (samp && isW) {
#pragma unroll 1
        for (int i = 32; i < 64; ++i) X[i * 132 + d] = 0.f; } }
    __syncthreads();
    { const int i = tid >> 3, d0 = (tid & 7) * 16;
#pragma unroll
      for (int c4 = 0; c4 < 4; ++c4) *(f32x4*)((float*)gp + i * 128 + d0 + c4 * 4) = *(const LAS f32x4*)(sv + i * 132 + d0 + c4 * 4);
#pragma unroll
      for (int c8 = 0; c8 < 2; ++c8) { float x[8];
#pragma unroll
        for (int q = 0; q < 8; ++q) x[q] = -sW[i * 132 + d0 + c8 * 8 + q];
        *(u32x4*)((bf16_t*)(gp + 32768) + i * 128 + d0 + c8 * 8) = pack8(x); } }
    __syncthreads();
}

#define LDS_BARRIER() do { asm volatile("s_waitcnt lgkmcnt(0)" ::: "memory"); __builtin_amdgcn_s_barrier(); asm volatile("" ::: "memory"); } while (0)
#ifndef REP_SCAN
#define REP_SCAN 1
#endif
struct ScanOps { bf16x8 aw[4], aq[4], aqk[2], akd[2]; f32x4 u; float eg; };
DI void scan_load(ScanOps& o, const unsigned char* gp, int w, int mt, int nt, int sl, int c16, int g) {
    const bf16_t* NW = (const bf16_t*)(gp + 32768); const bf16_t* QG = (const bf16_t*)(gp + 49152); const bf16_t* KDT = (const bf16_t*)(gp + 65536); const bf16_t* QK = (const bf16_t*)(gp + 81920);
#pragma unroll
    for (int ks = 0; ks < 4; ++ks) { o.aw[ks] = *(const bf16x8*)(NW + (16 * mt + c16) * 128 + 32 * ks + 8 * g); o.aq[ks] = *(const bf16x8*)(QG + (16 * mt + c16) * 128 + 32 * ks + 8 * g); }
#pragma unroll
    for (int ks = 0; ks < 2; ++ks) { o.aqk[ks] = *(const bf16x8*)(QK + (16 * mt + c16) * 64 + 32 * ks + 8 * g); o.akd[ks] = *(const bf16x8*)(KDT + (16 * w + c16) * 64 + 32 * ks + 8 * g); }
    const float* U = (const float*)gp + sl * 32 + 16 * nt + c16;
#pragma unroll
    for (int j = 0; j < 4; ++j) o.u[j] = U[(16 * mt + 4 * g + j) * 128];
    o.eg = *(const float*)(gp + 90112);
}
DI void scan_item(const Params& p, int sitem, LAS unsigned char* lds, int tid) {
    unsigned char* ws = p.ws;
    int seq, h, sl, nch; if (sitem < 64) { seq = sitem >> 5; h = (sitem >> 2) & 7; sl = sitem & 3; nch = 64; } else { const int x = sitem - 64; seq = 2 + (x >> 5); h = (x >> 2) & 7; sl = x & 3; nch = 1; }
    const bool samp = seq >= 2; const int ntok = samp ? 32 : 64;
    LAS bf16_t* St = (LAS bf16_t*)lds; LAS bf16_t* Vn = St + 32 * 136;
    const int w = tid >> 6, lane = tid & 63, g = lane >> 4, c16 = lane & 15, mt = w & 3, nt = w >> 2;
    f32x4 Sacc[2];
#pragma unroll
    for (int n2 = 0; n2 < 2; ++n2)
#pragma unroll
      for (int j = 0; j < 4; ++j) Sacc[n2][j] = samp ? p.in[3][((size_t)((seq - 2) * 8 + h) * 128 + 16 * w + 4 * g + j) * 128 + sl * 32 + 16 * n2 + c16] : 0.f;
#pragma unroll
    for (int n2 = 0; n2 < 2; ++n2) { u32x2 pw; pw.x = pk2(Sacc[n2][0], Sacc[n2][1]); pw.y = pk2(Sacc[n2][2], Sacc[n2][3]); *(LAS u32x2*)(St + (16 * n2 + c16) * 136 + 16 * w + 4 * g) = pw; }
    const int gitem0 = samp ? 1024 + (seq - 2) * 8 + h : (seq * 64) * 8 + h;
    const unsigned char* gp0 = ws + OFF_GP + (size_t)gitem0 * GP_STRIDE;
    ScanOps ring[3];
    scan_load(ring[0], gp0, w, mt, nt, sl, c16, g);
    scan_load(ring[1], gp0 + (size_t)(nch > 1 ? 8 : 0) * GP_STRIDE, w, mt, nt, sl, c16, g);
    __syncthreads();
    bf16_t* GO = (bf16_t*)(ws + OFF_GO);
#define SCAN_STEP(CUR, NXT2, ch_) do { const int ch = (ch_); \
      scan_load(ring[NXT2], gp0 + (size_t)(ch + 2 < nch ? ch + 2 : nch - 1) * 8 * GP_STRIDE, w, mt, nt, sl, c16, g);     \
      const int r0 = samp ? MPR + (seq - 2) * 32 : seq * 4096 + ch * 64; \
      f32x4 vacc = ring[CUR].u, oacc = {0.f, 0.f, 0.f, 0.f}; \
      _Pragma("unroll") for (int ks = 0; ks < 4; ++ks) { const bf16x8 bs = *(const LAS bf16x8*)(St + (16 * nt + c16) * 136 + 32 * ks + 8 * g); vacc = mfma16(ring[CUR].aw[ks], bs, vacc); oacc = mfma16(ring[CUR].aq[ks], bs, oacc); } \
      { u32x2 pw; pw.x = pk2(vacc[0], vacc[1]); pw.y = pk2(vacc[2], vacc[3]); *(LAS u32x2*)(Vn + (16 * nt + c16) * 72 + 16 * mt + 4 * g) = pw; } \
      LDS_BARRIER(); \
      _Pragma("unroll") for (int ks = 0; ks < 2; ++ks) { const bf16x8 bv = *(const LAS bf16x8*)(Vn + (16 * nt + c16) * 72 + 32 * ks + 8 * g); oacc = mfma16(ring[CUR].aqk[ks], bv, oacc); } \
      _Pragma("unroll") for (int j = 0; j < 4; ++j) { const int c = 16 * mt + 4 * g + j; if (c < ntok) GO[(size_t)(r0 + c) * 1024 + h * 128 + sl * 32 + 16 * nt + c16] = f2bf(oacc[j]); } \
      _Pragma("unroll") for (int n2 = 0; n2 < 2; ++n2) { Sacc[n2] *= ring[CUR].eg; \
        _Pragma("unroll") for (int ks = 0; ks < 2; ++ks) { const bf16x8 bv = *(const LAS bf16x8*)(Vn + (16 * n2 + c16) * 72 + 32 * ks + 8 * g); Sacc[n2] = mfma16(ring[CUR].akd[ks], bv, Sacc[n2]); } \
        u32x2 pw; pw.x = pk2(Sacc[n2][0], Sacc[n2][1]); pw.y = pk2(Sacc[n2][2], Sacc[n2][3]); *(LAS u32x2*)(St + (16 * n2 + c16) * 136 + 16 * w + 4 * g) = pw; } \
      LDS_BARRIER(); } while (0)
    int ch3 = 0;
    for (; ch3 + 3 <= nch; ch3 += 3) { SCAN_STEP(0, 2, ch3); SCAN_STEP(1, 0, ch3 + 1); SCAN_STEP(2, 1, ch3 + 2); }
    if (ch3 < nch) SCAN_STEP(0, 2, ch3);
    if (ch3 + 1 < nch) SCAN_STEP(1, 0, ch3 + 1);
#undef SCAN_STEP
    float* So = p.out + (samp ? O_SSMS + (size_t)((seq - 2) * 8 + h) * 16384 : O_SSMP + (size_t)(seq * 8 + h) * 16384);
#pragma unroll
    for (int n2 = 0; n2 < 2; ++n2)
#pragma unroll
      for (int j = 0; j < 4; ++j) So[(size_t)(16 * w + 4 * g + j) * 128 + sl * 32 + 16 * n2 + c16] = Sacc[n2][j];
}
DI void pattn_item(const Params& p, int item, LAS unsigned char* lds, int tid) {
    unsigned char* ws = p.ws;
    const int qt = 15 - (item >> 4), b = (item >> 3) & 1, h = item & 7;
    const int w = tid >> 6, lane = tid & 63, g = lane >> 4, c16 = lane & 15;
    const int cq = 4 * qt + (w >> 1), nkt = 4 * qt + 4;
    LAS bf16_t* Kt = (LAS bf16_t*)lds;
    LAS bf16_t* Vt = Kt + 2 * 64 * 200;
    const bf16_t* KV = (const bf16_t*)(ws + OFF_KV) + (size_t)(b * 4096) * 2048 + h * 128;
    const bf16_t* KR = (const bf16_t*)(ws + OFF_KRB) + (size_t)(b * 4096) * 64;
    bf16x8 qf[2][6];
#pragma unroll
    for (int sb = 0; sb < 2; ++sb) { const bf16_t* q = (const bf16_t*)(ws + OFF_QP) + ((size_t)(b * 4096 + 256 * qt + 32 * w + 16 * sb + c16) * 8 + h) * 192 + 8 * g;
#pragma unroll
      for (int ks = 0; ks < 6; ++ks) qf[sb][ks] = *(const bf16x8*)(q + 32 * ks); }
    u32x4 ld[5];
    const int kr0 = tid >> 4, kc0 = (tid & 15) * 8;
    const int rr = tid >> 3, rc = (tid & 7) * 8;
#define PA_LOAD(kt) do { const size_t kb = (size_t)(kt) * 64; \
      ld[0] = *(const u32x4*)(KV + (kb + kr0) * 2048 + kc0); ld[1] = *(const u32x4*)(KV + (kb + kr0 + 32) * 2048 + kc0); \
      ld[2] = *(const u32x4*)(KV + (kb + kr0) * 2048 + 1024 + kc0); ld[3] = *(const u32x4*)(KV + (kb + kr0 + 32) * 2048 + 1024 + kc0); \
      ld[4] = *(const u32x4*)(KR + (kb + rr) * 64 + rc); } while (0)
#define PA_STORE(buf) do { LAS bf16_t* kd = Kt + (buf) * 64 * 200; LAS bf16_t* vd = Vt + (buf) * 64 * 144; \
      *(LAS u32x4*)(kd + kr0 * 200 + kc0) = ld[0]; *(LAS u32x4*)(kd + (kr0 + 32) * 200 + kc0) = ld[1]; \
      *(LAS u32x4*)(vd + kr0 * 144 + kc0) = ld[2]; *(LAS u32x4*)(vd + (kr0 + 32) * 144 + kc0) = ld[3]; \
      *(LAS u32x4*)(kd + rr * 200 + 128 + rc) = ld[4]; } while (0)
    PA_LOAD(0); PA_STORE(0);
    if (nkt > 1) PA_LOAD(1);
    __syncthreads();
    f32x4 oacc[2][8];
#pragma unroll
    for (int sb = 0; sb < 2; ++sb)
#pragma unroll
      for (int m = 0; m < 8; ++m) oacc[sb][m] = (f32x4){0.f, 0.f, 0.f, 0.f};
    float m_run[2] = {-1e30f, -1e30f}, l_run[2] = {0.f, 0.f};
    const int tq = c16 >> 2, tp = c16 & 3;
    for (int kt = 0; kt < nkt; ++kt) {
      const int buf = kt & 1;
      if (kt + 1 < nkt) { PA_STORE(buf ^ 1); if (kt + 2 < nkt) PA_LOAD(kt + 2); }
      if (kt <= cq) {
        const LAS bf16_t* kb = Kt + buf * 64 * 200; const LAS bf16_t* vb = Vt + buf * 64 * 144;
        f32x4 sacc[2][4];
#pragma unroll
        for (int t16 = 0; t16 < 4; ++t16) { bf16x8 kf[6];
#pragma unroll
          for (int ks = 0; ks < 6; ++ks) kf[ks] = *(const LAS bf16x8*)(kb + (16 * t16 + c16) * 200 + 32 * ks + 8 * g);
          sacc[0][t16] = (f32x4){0.f, 0.f, 0.f, 0.f}; sacc[1][t16] = (f32x4){0.f, 0.f, 0.f, 0.f};
#pragma unroll
          for (int ks = 0; ks < 6; ++ks) { sacc[0][t16] = mfma16(kf[ks], qf[0][ks], sacc[0][t16]); sacc[1][t16] = mfma16(kf[ks], qf[1][ks], sacc[1][t16]); } }
        bf16x8 pb[2][2];
#pragma unroll
        for (int sb = 0; sb < 2; ++sb) {
          float mx = sacc[sb][0][0];
#pragma unroll
          for (int t16 = 0; t16 < 4; ++t16)
#pragma unroll
            for (int j = 0; j < 4; ++j) mx = fmaxf(mx, sacc[sb][t16][j]);
          mx = fmaxf(mx, __shfl_xor(mx, 16)); mx = fmaxf(mx, __shfl_xor(mx, 32));
          const float mn = fmaxf(m_run[sb], mx), alpha = exp2f(m_run[sb] - mn); m_run[sb] = mn;
          float ps = 0.f;
#pragma unroll
          for (int t16 = 0; t16 < 4; ++t16)
#pragma unroll
            for (int j = 0; j < 4; ++j) { sacc[sb][t16][j] = exp2f(sacc[sb][t16][j] - mn); ps += sacc[sb][t16][j]; }
          l_run[sb] = l_run[sb] * alpha + ps;
#pragma unroll
          for (int m = 0; m < 8; ++m) oacc[sb][m] *= alpha;
#pragma unroll
          for (int s = 0; s < 2; ++s) { u32x4 pw; pw.x = pk2(sacc[sb][2 * s][0], sacc[sb][2 * s][1]); pw.y = pk2(sacc[sb][2 * s][2], sacc[sb][2 * s][3]); pw.z = pk2(sacc[sb][2 * s + 1][0], sacc[sb][2 * s + 1][1]); pw.w = pk2(sacc[sb][2 * s + 1][2], sacc[sb][2 * s + 1][3]);
            pb[sb][s] = __builtin_bit_cast(bf16x8, pw); } }
#pragma unroll
        for (int s = 0; s < 2; ++s)
#pragma unroll
          for (int mh = 0; mh < 2; ++mh) { s16x4 vf[4][2];
#pragma unroll
            for (int m4 = 0; m4 < 4; ++m4) { const int m = 4 * mh + m4; vf[m4][0] = tr_read(vb + (32 * s + 4 * g + tq) * 144 + 16 * m + 4 * tp); vf[m4][1] = tr_read(vb + (32 * s + 16 + 4 * g + tq) * 144 + 16 * m + 4 * tp); }
#pragma unroll
            for (int m4 = 0; m4 < 4; ++m4) { const int m = 4 * mh + m4; const bf16x8 va = __builtin_shufflevector(vf[m4][0], vf[m4][1], 0, 1, 2, 3, 4, 5, 6, 7);
              oacc[0][m] = mfma16(va, pb[0][s], oacc[0][m]); oacc[1][m] = mfma16(va, pb[1][s], oacc[1][m]); } }
      }
      __syncthreads();
    }
#undef PA_LOAD
#undef PA_STORE
#pragma unroll
    for (int sb = 0; sb < 2; ++sb) { float l = l_run[sb]; l += __shfl_xor(l, 16); l += __shfl_xor(l, 32);
      const float il = 1.0f / l;
      bf16_t* o = (bf16_t*)(ws + OFF_OM) + (size_t)(b * 4096 + 256 * qt + 32 * w + 16 * sb + c16) * 1024 + h * 128 + 4 * g;
#pragma unroll
      for (int m = 0; m < 8; ++m) { u32x2 pw; pw.x = pk2(oacc[sb][m][0] * il, oacc[sb][m][1] * il); pw.y = pk2(oacc[sb][m][2] * il, oacc[sb][m][3] * il); *(u32x2*)(o + 16 * m) = pw; } }
}

DI void sattn_item(const Params& p, int item, LAS unsigned char* lds, int tid) {
    unsigned char* ws = p.ws;
    const int b = item >> 4, hg = (item >> 2) & 3, sp = item & 3;
    const int w = tid >> 6, lane = tid & 63, g = lane >> 4, c16 = lane & 15, qs = w & 3, dh = w >> 2;
    LAS bf16_t* Qs = (LAS bf16_t*)lds;
    LAS bf16_t* Kt = Qs + 64 * 584;
    const int t_lo = sp * 32, t_hi = sp == 3 ? 129 : sp * 32 + 32;
    const float* ck = p.in[4] + (size_t)b * 4096 * 512; const float* kr = p.in[5] + (size_t)b * 4096 * 64;
    const bf16_t* ckn = (const bf16_t*)(ws + OFF_CKVB) + (size_t)(MPR + b * 32) * 512; const bf16_t* krn = (const bf16_t*)(ws + OFF_KRB) + (size_t)(MPR + b * 32) * 64;
    { const bf16_t* q0 = (const bf16_t*)(ws + OFF_QS) + (size_t)(b * 8 + 2 * hg) * 32 * 576;
      const int row = tid >> 3, c = tid & 7;
#pragma unroll
      for (int i = 0; i < 9; ++i) *(LAS u32x4*)(Qs + row * 584 + (c + 8 * i) * 8) = *(const u32x4*)(q0 + (size_t)row * 576 + (c + 8 * i) * 8); }
    float4 ld[9];
    const int lk = tid >> 7, lc = tid & 127, rk = tid >> 4, rc4 = tid & 15;
#define SA_LOAD(tile) do { if ((tile) < 128) { const float* s_ = ck + (size_t)((tile) * 32 + lk) * 512 + lc * 4; \
        _Pragma("unroll") for (int i = 0; i < 8; ++i) ld[i] = *(const float4*)(s_ + i * 2048); \
        ld[8] = *(const float4*)(kr + (size_t)((tile) * 32 + rk) * 64 + rc4 * 4); } \
      else { const bf16_t* s_ = ckn + lk * 512 + lc * 4; \
        _Pragma("unroll") for (int i = 0; i < 8; ++i) { const u32x2 v = *(const u32x2*)(s_ + i * 2048); ld[i] = make_float4(bflo(v.x), bfhi(v.x), bflo(v.y), bfhi(v.y)); } \
        const u32x2 v = *(const u32x2*)(krn + rk * 64 + rc4 * 4); ld[8] = make_float4(bflo(v.x), bfhi(v.x), bflo(v.y), bfhi(v.y)); } } while (0)
#define SA_STORE(buf) do { LAS bf16_t* kd = Kt + (buf) * 32 * 584; \
        _Pragma("unroll") for (int i = 0; i < 8; ++i) { u32x2 v; v.x = pk2(ld[i].x, ld[i].y); v.y = pk2(ld[i].z, ld[i].w); *(LAS u32x2*)(kd + (lk + 4 * i) * 584 + lc * 4) = v; } \
        { u32x2 v; v.x = pk2(ld[8].x, ld[8].y); v.y = pk2(ld[8].z, ld[8].w); *(LAS u32x2*)(kd + rk * 584 + 512 + rc4 * 4) = v; } } while (0)
    SA_LOAD(t_lo); SA_STORE(0);
    SA_LOAD(t_lo + 1);
    __syncthreads();
    f32x4 oacc[16];
#pragma unroll
    for (int m = 0; m < 16; ++m) oacc[m] = (f32x4){0.f, 0.f, 0.f, 0.f};
    float m_run = -1e30f, l_run = 0.f;
    const int tq = c16 >> 2, tp = c16 & 3;
    for (int tile = t_lo; tile < t_hi; ++tile) {
      const int buf = (tile - t_lo) & 1;
      if (tile + 1 < t_hi) { SA_STORE(buf ^ 1); if (tile + 2 < t_hi) SA_LOAD(tile + 2); }
      const LAS bf16_t* kb = Kt + buf * 32 * 584;
      f32x4 sacc[2] = {(f32x4){0.f, 0.f, 0.f, 0.f}, (f32x4){0.f, 0.f, 0.f, 0.f}};
      bf16x8 fr[2][2][3];
#define SA_FRAGS(dst, grp) do { _Pragma("unroll") for (int k6 = 0; k6 < 2; ++k6) { const int ks = (grp) * 2 + k6; \
        dst[k6][0] = *(const LAS bf16x8*)(Qs + (16 * qs + c16) * 584 + 32 * ks + 8 * g); \
        dst[k6][1] = *(const LAS bf16x8*)(kb + c16 * 584 + 32 * ks + 8 * g); dst[k6][2] = *(const LAS bf16x8*)(kb + (16 + c16) * 584 + 32 * ks + 8 * g); } } while (0)
      SA_FRAGS(fr[0], 0);
#pragma unroll
      for (int grp = 0; grp < 9; ++grp) {
        if (grp < 8) SA_FRAGS(fr[(grp + 1) & 1], grp + 1);
        __builtin_amdgcn_sched_barrier(0);
#pragma unroll
        for (int k6 = 0; k6 < 2; ++k6) { sacc[0] = mfma16(fr[grp & 1][k6][1], fr[grp & 1][k6][0], sacc[0]); sacc[1] = mfma16(fr[grp & 1][k6][2], fr[grp & 1][k6][0], sacc[1]); }
        __builtin_amdgcn_sched_barrier(0); }
#undef SA_FRAGS
      float mx = sacc[0][0];
#pragma unroll
      for (int t16 = 0; t16 < 2; ++t16)
#pragma unroll
        for (int j = 0; j < 4; ++j) mx = fmaxf(mx, sacc[t16][j]);
      mx = fmaxf(mx, __shfl_xor(mx, 16)); mx = fmaxf(mx, __shfl_xor(mx, 32));
      const float mn = fmaxf(m_run, mx), alpha = exp2f(m_run - mn); m_run = mn;
      float ps = 0.f;
#pragma unroll
      for (int t16 = 0; t16 < 2; ++t16)
#pragma unroll
        for (int j = 0; j < 4; ++j) { sacc[t16][j] = exp2f(sacc[t16][j] - mn); ps += sacc[t16][j]; }
      l_run = l_run * alpha + ps;
      u32x4 pw; pw.x = pk2(sacc[0][0], sacc[0][1]); pw.y = pk2(sacc[0][2], sacc[0][3]); pw.z = pk2(sacc[1][0], sacc[1][1]); pw.w = pk2(sacc[1][2], sacc[1][3]);
      const bf16x8 pb = __builtin_bit_cast(bf16x8, pw);
      s16x4 vf[2][4][2];
#define SA_VF(dst, q4) do { _Pragma("unroll") for (int m = 0; m < 4; ++m) { dst[m][0] = tr_read(kb + (4 * g + tq) * 584 + 256 * dh + 16 * (4 * (q4) + m) + 4 * tp); \
        dst[m][1] = tr_read(kb + (16 + 4 * g + tq) * 584 + 256 * dh + 16 * (4 * (q4) + m) + 4 * tp); } } while (0)
      SA_VF(vf[0], 0);
#pragma unroll
      for (int q4 = 0; q4 < 4; ++q4) {
        if (q4 < 3) SA_VF(vf[(q4 + 1) & 1], q4 + 1);
#pragma unroll
        for (int m = 0; m < 4; ++m) oacc[4 * q4 + m] *= alpha;
        __builtin_amdgcn_sched_barrier(0);
#pragma unroll
        for (int m = 0; m < 4; ++m) { const bf16x8 va = __builtin_shufflevector(vf[q4 & 1][m][0], vf[q4 & 1][m][1], 0, 1, 2, 3, 4, 5, 6, 7); oacc[4 * q4 + m] = mfma16(va, pb, oacc[4 * q4 + m]); }
        __builtin_amdgcn_sched_barrier(0); }
#undef SA_VF
      __syncthreads();
    }
#undef SA_LOAD
#undef SA_STORE
    l_run += __shfl_xor(l_run, 16); l_run += __shfl_xor(l_run, 32);
    const int qrow = 16 * qs + c16, h = 2 * hg + (qrow >> 5), t = qrow & 31;
    const size_t prow = (size_t)((b * 8 + h) * 4 + sp) * 32 + t;
    bf16_t* po = (bf16_t*)(ws + OFF_PO) + prow * 512 + 256 * dh + 4 * g;
#pragma unroll
    for (int m = 0; m < 16; ++m) { u32x2 pw; pw.x = pk2(oacc[m][0], oacc[m][1]); pw.y = pk2(oacc[m][2], oacc[m][3]); *(u32x2*)(po + 16 * m) = pw; }
    if (dh == 0 && g == 0) { float* ml = (float*)(ws + OFF_ML) + prow * 2; ml[0] = m_run; ml[1] = l_run; }
}

DI void og_row(const Params& p, int r, int lane) {
    unsigned char* ws = p.ws;
    const bf16_t* o = (const bf16_t*)(ws + OFF_GO) + (size_t)r * 1024 + lane * 16;
    float x[16]; unpack8(*(const u32x4*)o, x); unpack8(*(const u32x4*)(o + 8), x + 8);
    float ss = 0.f;
#pragma unroll
    for (int c = 0; c < 16; ++c) ss += x[c] * x[c];
    ss += __shfl_xor(ss, 1); ss += __shfl_xor(ss, 2); ss += __shfl_xor(ss, 4);
    const float rn = rsqrtf(ss * (1.0f / 128.0f) + NEPS);
    const bf16_t* z = (const bf16_t*)(ws + OFF_R1) + (size_t)r * DINP + C_Z + lane * 16;
    float zz[16]; unpack8(*(const u32x4*)z, zz); unpack8(*(const u32x4*)(z + 8), zz + 8);
    const float* gw = p.in[16] + (lane & 7) * 16;
#pragma unroll
    for (int c = 0; c < 16; ++c) x[c] = x[c] * rn * gw[c] * silu_f(zz[c]);
    bf16_t* og = (bf16_t*)(ws + OFF_OG) + (size_t)r * 1024 + lane * 16;
    *(u32x4*)og = pack8(x); *(u32x4*)(og + 8) = pack8(x + 8);
}
DI void scomb_item(const Params& p, int b, int h, LAS bf16_t* ol, int tid) {
    unsigned char* ws = p.ws;
    const bf16_t* PO = (const bf16_t*)(ws + OFF_PO) + (size_t)((b * 8 + h) * 4) * 32 * 512; const float* ML = (const float*)(ws + OFF_ML) + (size_t)((b * 8 + h) * 4) * 32 * 2;
#pragma unroll 4
    for (int t = 0; t < 32; ++t) { float m[4], l[4], mx = -1e30f;
#pragma unroll
      for (int s = 0; s < 4; ++s) { m[s] = ML[(s * 32 + t) * 2]; l[s] = ML[(s * 32 + t) * 2 + 1]; mx = fmaxf(mx, m[s]); }
      float L = 0.f, acc = 0.f;
#pragma unroll
      for (int s = 0; s < 4; ++s) { const float ws_ = exp2f(m[s] - mx); L += ws_ * l[s]; acc += ws_ * bf2f(PO[(size_t)(s * 32 + t) * 512 + tid]); }
      ol[t * 520 + tid] = f2bf(acc / L); }
    __syncthreads();
    const int w = tid >> 6, lane = tid & 63, g = lane >> 4, c16 = lane & 15;
    const bf16_t* wt = (const bf16_t*)(ws + OFF_WUV) + (size_t)(h * 128 + 16 * w + c16) * 512 + 8 * g;
    bf16x8 wb[16];
#pragma unroll
    for (int ks = 0; ks < 16; ++ks) wb[ks] = *(const bf16x8*)(wt + 32 * ks);
    f32x4 acc[2] = {(f32x4){0.f, 0.f, 0.f, 0.f}, (f32x4){0.f, 0.f, 0.f, 0.f}};
#pragma unroll
    for (int ks = 0; ks < 16; ++ks)
#pragma unroll
      for (int mt = 0; mt < 2; ++mt) { const bf16x8 a = *(const LAS bf16x8*)(ol + (16 * mt + c16) * 520 + 32 * ks + 8 * g); acc[mt] = mfma16(a, wb[ks], acc[mt]); }
    bf16_t* om = (bf16_t*)(ws + OFF_OM) + (size_t)(MPR + b * 32) * 1024 + h * 128 + 16 * w + c16;
#pragma unroll
    for (int mt = 0; mt < 2; ++mt)
#pragma unroll
      for (int j = 0; j < 4; ++j) om[(size_t)(16 * mt + 4 * g + j) * 1024] = f2bf(acc[mt][j]);
    __syncthreads();
}
#ifndef GEMM_SP2
#define GEMM_SP2 true
#endif
#ifndef GEMM_ALIGN
#define GEMM_ALIGN true
#endif
template <class Epi>
DI void run_gemm(LAS unsigned char* lds, const bf16_t* A, const bf16_t* Bt, int M, int N, int K, const Epi& E, int G, int c) {
    pg8::Gemm g{A, Bt, M, N, K, K, K}; pg8::StaticOrder S; S.init(M, N, G, c);
    pg8::gemm_phase<Epi, pg8::StaticOrder, GEMM_ALIGN, GEMM_SP2>((PG8_LAS unsigned char*)lds, g, S, E);
}
struct OneUnit { int pm, pn;
    DI bool next(int i, pg8::Unit& u) const { if (i) return false; u.pm = pm; u.pn = pn; return true; }
    DI void a_ready(const pg8::Unit&) const {}
    DI void done(const pg8::Unit&) const {} };
template <class Epi>
DI void run_gemm_split_e(LAS unsigned char* lds, const bf16_t* A, const bf16_t* Bt, int K, int ksub, const Epi& E, int c) {
    const int s = c >> 4, u = c & 15;
    pg8::Gemm g{A + (size_t)s * ksub, Bt + (size_t)s * ksub, MT, D, ksub, K, K}; OneUnit S{32 + (u >> 3), u & 7};
    pg8::gemm_phase<Epi, OneUnit, GEMM_ALIGN, GEMM_SP2>((PG8_LAS unsigned char*)lds, g, S, E);
}
DI void run_gemm_split(LAS unsigned char* lds, const bf16_t* A, const bf16_t* Bt, int K, int ksub, float* part, int c) {
    const int nsplit = K / ksub;
    if (c >= 16 * nsplit) return;
    pg8::EpiBf16P E{(bf16_t*)part + (size_t)(c >> 4) * 512 * D - (size_t)MPR * D, D};
    run_gemm_split_e(lds, A, Bt, K, ksub, E, c);
}
#ifndef REP_PREP
#define REP_PREP 1
#endif
#ifndef REP_SCAN
#define REP_SCAN 1
#endif
#ifndef REP_PATTN
#define REP_PATTN 1
#endif
#ifndef REP_SATTN
#define REP_SATTN 1
#endif
#ifndef REP_P0
#define REP_P0 1
#endif
#ifndef REP_P1
#define REP_P1 1
#endif
#ifndef REP_P5
#define REP_P5 1
#endif
#ifndef REP_P7
#define REP_P7 1
#endif
__global__ void __launch_bounds__(512, 2) fwd_megakernel(Params p) {
    extern __shared__ __attribute__((aligned(16))) unsigned char smem[];
    LAS unsigned char* lds = (LAS unsigned char*)smem;
    cg::grid_group grid = cg::this_grid();
    int tid = threadIdx.x, lane = tid & 63, wv = tid >> 6; const int G = gridDim.x, bid = blockIdx.x;
#define FRESH_TID() do { tid = threadIdx.x; asm volatile("" : "+v"(tid)); lane = tid & 63; wv = tid >> 6; } while (0)
    unsigned char* ws = p.ws;
    bf16_t* XN = (bf16_t*)(ws + OFF_XN); bf16_t* R1 = (bf16_t*)(ws + OFF_R1); float* F = (float*)(ws + OFF_F); float* Y = p.out;
    unsigned* ctl = (unsigned*)(ws + OFF_CTL); float* FP = (float*)(ws + OFF_KV); bf16_t* FB = (bf16_t*)(ws + OFF_F); bf16_t* XB2 = (bf16_t*)(ws + OFF_GP); bf16_t* XB1 = (bf16_t*)p.out;
    LAS int* s_item = (LAS int*)(lds + LDS_CTL);
    if (tid < 8) ((LAS unsigned*)(lds + LDS_CTL))[tid] = 0u;
    __syncthreads();
    if (p.out == nullptr) grid.sync();
    XcdBarrier xb = xcd_barrier_post((unsigned*)(ws + OFF_BAR), (volatile LAS unsigned*)(lds + LDS_CTL + 16));

#define DRAIN_TR() do { for (;;) { __syncthreads(); if (tid == 0) *s_item = (int)atomicAdd(ctl + 2, 1u); __syncthreads(); const int q_ = *s_item; if (q_ >= 2112) break; \
      bool any_; transpose_pass4((LAS float*)lds, p, q_ * 4, tjob_p3, tid, any_); } } while (0)
#define DRAIN_LATE() do { for (;;) { __syncthreads(); if (tid == 0) *s_item = (int)atomicAdd(ctl + 3, 1u); __syncthreads(); const int q_ = *s_item; if (q_ >= 640) break; \
      bool any_; transpose_pass4((LAS float*)lds, p, q_ * 4, tjob_late, tid, any_); } } while (0)
#define DRAIN_WIN() do { for (;;) { __syncthreads(); if (tid == 0) *s_item = (int)atomicAdd(ctl + 4, 1u); __syncthreads(); const int q_ = *s_item; if (q_ >= 1296) break; \
      bool any_; transpose_pass4((LAS float*)lds, p, q_ * 4, tjob_win, tid, any_); } } while (0)
    if (tid == 0) { const unsigned x = (unsigned)__builtin_amdgcn_s_getreg((3 << 11) | 20) & 0xFu; const unsigned slot = atomicAdd(ctl + 16 + (x & 7u), 1u); s_item[1] = (int)(slot * 8u + (x & 7u)); }
    for (int r = bid * 8 + wv; r < MT; r += G * 8) rowop<false, false, true>(xin_row(p, r), nullptr, nullptr, 0, 0.f, nullptr, p.in[6], nullptr, XN + (size_t)r * D, lane);
    _Pragma("unroll") for (int rep = 0; rep < REP_P0; ++rep) {
    for (int t = bid * 4;; t += G * 4) { bool any; transpose_pass4((LAS float*)lds, p, t, tjob_p0, tid, any); if (!any) break; }
    xcd_barrier(xb); FRESH_TID(); }
    int gid = bid;
    { bool ok = (G % 8) == 0;
      for (int x = 0; x < 8; ++x) ok = ok && (__hip_atomic_load(ctl + 16 + x, __ATOMIC_RELAXED, __HIP_MEMORY_SCOPE_AGENT) == (unsigned)(G / 8));
      if (ok) gid = s_item[1]; }
    gid = __builtin_amdgcn_readfirstlane(gid);
    _Pragma("unroll") for (int rep = 0; rep < REP_P1; ++rep) {
    { pg8::EpiSwiglu E{R1, DFF}; run_gemm(lds, XN, (const bf16_t*)(ws + OFF_WGU), MT, 2 * DFF, D, E, G, gid); }
    DRAIN_LATE(); DRAIN_WIN();
    xcd_barrier(xb); FRESH_TID(); }
    { pg8::EpiBf16P E{FB, D}; run_gemm(lds, R1, (const bf16_t*)(ws + OFF_WD), MPR, D, DFF, E, G, gid); }
    __syncthreads();
    run_gemm_split(lds, R1, (const bf16_t*)(ws + OFF_WD), DFF, 512, FP, G - 1 - gid);
    __syncthreads(); DRAIN_WIN();
    xcd_barrier(xb); FRESH_TID();
    for (int r = bid * 8 + wv; r < MT; r += G * 8) rowop<true, true, true, false, true>(xin_row(p, r), r < MPR ? nullptr : (const float*)((const bf16_t*)FP + (size_t)(r - MPR) * D), r < MPR ? FB + (size_t)r * D : nullptr, r < MPR ? 1 : 11, 0.5f, p.in[10], p.in[11], nullptr, XN + (size_t)r * D, lane, nullptr, XB1 + (size_t)r * D);
    DRAIN_WIN();
    xcd_barrier(xb); FRESH_TID();
    { pg8::EpiBf16P E{R1, DINP}; run_gemm(lds, XN, (const bf16_t*)(ws + OFF_WIN), MT, DINP, D, E, G, gid); }
    DRAIN_LATE();
    DRAIN_TR();
    xcd_barrier(xb); FRESH_TID();
    _Pragma("unroll") for (int rep = 0; rep < REP_P5; ++rep) {
    for (int r = bid * 8 + wv; r < MT; r += G * 8) mla_prep_row(p, r, lane);
    for (int i = bid * 512 + tid; i < 18 * 3 * 3072; i += G * 512) { const int seq = i / 9216, rem = i % 9216, jr = rem / 3072, c = rem % 3072;
        const int row = seq < 2 ? seq * 4096 + 4093 + jr : MPR + (seq - 2) * 32 + 29 + jr;
        const float v = bf2f(R1[(size_t)row * DINP + c]);
        if (seq < 2) Y[O_CONVP + (size_t)(seq * 3 + jr) * 3072 + c] = v; else Y[O_CONVS + (size_t)((seq - 2) * 3 + jr) * 3072 + c] = v; }
#ifndef SK_QLAT
    for (int it = bid; it < 128; it += G) qlat_item(p, it >> 3, it & 7, tid);
#endif
#ifndef SK_PREP
    for (int rp = 0; rp < REP_PREP; ++rp)
    for (int it = bid; it < 1152; it += G) gdn_prep_item(p, it, lds, tid);
#endif
    xcd_barrier(xb); FRESH_TID(); }
    { pg8::EpiBf16P E{(bf16_t*)(ws + OFF_KV), 2048}; run_gemm(lds, (const bf16_t*)(ws + OFF_CKVB), (const bf16_t*)(ws + OFF_WUK), MPR, 2048, 512, E, G, gid); }
    xcd_barrier(xb); FRESH_TID();
    _Pragma("unroll") for (int rep = 0; rep < REP_P7; ++rep) {
#define FETCH_ITEM() do { __syncthreads(); if (tid == 0) *s_item = (int)atomicAdd(ctl + rep, 1u); __syncthreads(); it = *s_item; } while (0)
    {
      for (int i0 = gid; i0 < 64; i0 += G) { const int sit = ((i0 & 7) + 8 * (i0 >> 5)) * 4 + ((i0 >> 3) & 3); scan_item(p, sit, lds, tid); __syncthreads(); }
      int it; FETCH_ITEM();
      while (it < 128) { pattn_item(p, it, lds, tid); FETCH_ITEM(); }
      while (it < 384) { sattn_item(p, it - 128, lds, tid); FETCH_ITEM(); }
      while (it < 512) { pattn_item(p, it - 384 + 128, lds, tid); FETCH_ITEM(); }
      while (it < 1024) { scan_item(p, 64 + (it - 512), lds, tid); FETCH_ITEM(); }
    }
    DRAIN_TR();
    xcd_barrier(xb); FRESH_TID(); }
    for (int r = bid * 8 + wv; r < MT; r += G * 8) og_row(p, r, lane);
#ifndef SK_SCOMB
    for (int it = bid; it < 128; it += G) scomb_item(p, it >> 3, it & 7, (LAS bf16_t*)lds, tid);
#endif
    xcd_barrier(xb); FRESH_TID();
    { pg8::EpiGate1 E{FB, D, R1 + C_GG, DINP}; run_gemm(lds, (const bf16_t*)(ws + OFF_OG), (const bf16_t*)(ws + OFF_WBRG), MPR, D, 1024, E, G, gid); }
    __syncthreads();
    { pg8::EpiGate2 E{XN, D, FB, R1 + C_GM, DINP}; run_gemm(lds, (const bf16_t*)(ws + OFF_OM), (const bf16_t*)(ws + OFF_WBRM), MPR, D, 1024, E, G, gid); }
    __syncthreads();
    { const int c = G - 1 - gid;
      if (c < 64) { pg8::EpiGate1 E{(bf16_t*)FP + (size_t)(c >> 4) * 512 * D - (size_t)MPR * D, D, R1 + C_GG, DINP}; run_gemm_split_e(lds, (const bf16_t*)(ws + OFF_OG), (const bf16_t*)(ws + OFF_WBRG), 1024, 256, E, c); }
      else if (c < 128) { const int c2 = c - 64; pg8::EpiGate1 E{(bf16_t*)FP + (size_t)(4 + (c2 >> 4)) * 512 * D - (size_t)MPR * D, D, R1 + C_GM, DINP}; run_gemm_split_e(lds, (const bf16_t*)(ws + OFF_OM), (const bf16_t*)(ws + OFF_WBRM), 1024, 256, E, c2); } }
    xcd_barrier(xb); FRESH_TID();
    for (int r = bid * 8 + wv; r < 512; r += G * 8) {
      float4 v[8]; const bf16_t* fpb = (const bf16_t*)FP + (size_t)r * D;
#pragma unroll
      for (int i = 0; i < 8; ++i) { const u32x2 t = *(const u32x2*)(fpb + (i * 64 + lane) * 4); v[i] = make_float4(bflo(t.x), bfhi(t.x), bflo(t.y), bfhi(t.y)); }
#pragma unroll 1
      for (int s2 = 1; s2 < 8; ++s2) {
#pragma unroll
        for (int i = 0; i < 8; ++i) { const u32x2 t = *(const u32x2*)(fpb + (size_t)s2 * 512 * D + (i * 64 + lane) * 4); v[i].x += bflo(t.x); v[i].y += bfhi(t.x); v[i].z += bflo(t.y); v[i].w += bfhi(t.y); } }
#pragma unroll
      for (int i = 0; i < 8; ++i) { u32x2 pw; pw.x = pk2(v[i].x, v[i].y); pw.y = pk2(v[i].z, v[i].w); *(u32x2*)(XN + (size_t)(MPR + r) * D + (i * 64 + lane) * 4) = pw; } }
    xcd_barrier(xb); FRESH_TID();
    { pg8::EpiBf16P E{FB, D}; run_gemm(lds, XN, (const bf16_t*)(ws + OFF_WOUT), MPR, D, D, E, G, gid); }
    __syncthreads();
    run_gemm_split(lds, XN, (const bf16_t*)(ws + OFF_WOUT), D, 256, FP, G - 1 - gid);
    xcd_barrier(xb); FRESH_TID();
    for (int r = bid * 8 + wv; r < MT; r += G * 8) rowop<true, true, true, true, true>(nullptr, r < MPR ? nullptr : (const float*)((const bf16_t*)FP + (size_t)(r - MPR) * D), r < MPR ? FB + (size_t)r * D : nullptr, r < MPR ? 1 : 8, 1.0f, p.in[23], p.in[24], nullptr, XN + (size_t)r * D, lane, XB1 + (size_t)r * D, XB2 + (size_t)r * D);
    DRAIN_TR();
    xcd_barrier(xb); FRESH_TID();
    { pg8::EpiSwiglu E{R1, DFF}; run_gemm(lds, XN, (const bf16_t*)(ws + OFF_WGU), MT, 2 * DFF, D, E, G, gid); }
    xcd_barrier(xb); FRESH_TID();
    { pg8::EpiBf16P E{FB, D}; run_gemm(lds, R1, (const bf16_t*)(ws + OFF_WD), MPR, D, DFF, E, G, gid); }
    __syncthreads();
    run_gemm_split(lds, R1, (const bf16_t*)(ws + OFF_WD), DFF, 512, FP, G - 1 - gid);
    xcd_barrier(xb); FRESH_TID();
    for (int r = bid * 8 + wv; r < MT; r += G * 8) rowop<true, true, false, true, false>(nullptr, r < MPR ? nullptr : (const float*)((const bf16_t*)FP + (size_t)(r - MPR) * D), r < MPR ? FB + (size_t)r * D : nullptr, r < MPR ? 1 : 11, 0.5f, p.in[28], nullptr, Y + (size_t)r * D, nullptr, lane, XB2 + (size_t)r * D);
}

extern "C" void kernel_launch(void* const* d_in, const int* in_sizes, int n_in, void* d_out, int out_size, void* d_ws, size_t ws_size, hipStream_t stream) {
    static int grid_blocks = 0;
    if (grid_blocks == 0) {
        int dev = 0, cus = 0, per_cu = 0;
        hipGetDevice(&dev);
        hipDeviceGetAttribute(&cus, hipDeviceAttributeMultiprocessorCount, dev);
        if (hipFuncSetAttribute((const void*)fwd_megakernel, hipFuncAttributeMaxDynamicSharedMemorySize, LDS_BYTES) != hipSuccess) fprintf(stderr, "kernel_launch: hipFuncSetAttribute failed\n");
        if (hipOccupancyMaxActiveBlocksPerMultiprocessor(&per_cu, (const void*)fwd_megakernel, 512, LDS_BYTES) != hipSuccess || per_cu < 1) { fprintf(stderr, "kernel_launch: occupancy query gave %d\n", per_cu); per_cu = 1; }
        (void)hipGetLastError();
        grid_blocks = cus * (per_cu > 1 ? 1 : per_cu);
        if (ws_size < WS_END + 16384) fprintf(stderr, "kernel_launch: workspace too small: %zu < %zu\n", ws_size, (size_t)WS_END);
        if (n_in != 29) fprintf(stderr, "kernel_launch: expected 29 inputs, got %d\n", n_in);
    }
    if (hipMemsetAsync((unsigned char*)d_ws + OFF_BAR, 0, 16384, stream) != hipSuccess) fprintf(stderr, "kernel_launch: memset failed\n");
    if (hipMemsetAsync((unsigned char*)d_ws + OFF_CTL, 0, 4096, stream) != hipSuccess) fprintf(stderr, "kernel_launch: memset failed\n");
    Params p{};
    for (int i = 0; i < 29; ++i) p.in[i] = (const float*)d_in[i];
    p.out = (float*)d_out; p.ws = (unsigned char*)d_ws;
    void* args[] = {&p};
    hipError_t e = hipLaunchCooperativeKernel((const void*)fwd_megakernel, dim3(grid_blocks), dim3(512), args, LDS_BYTES, stream);
    if (e != hipSuccess) fprintf(stderr, "kernel_launch: cooperative launch failed: %s (grid %d)\n", hipGetErrorString(e), grid_blocks);
}
```

```cpp
#include <hip/hip_runtime.h>
#include <hip/hip_cooperative_groups.h>
#include <cstdio>
namespace cg = cooperative_groups;
namespace pg8 {
#define PG8_LAS __attribute__((address_space(3)))
typedef unsigned short bf16_t;
typedef short bf16x8 __attribute__((ext_vector_type(8)));
typedef float f32x4 __attribute__((ext_vector_type(4)));
typedef unsigned u32x4 __attribute__((ext_vector_type(4)));
constexpr int BM = 256, BK = 64, HALF = 128, HTB = HALF * BK * 2  , STAGE_BYTES = 8 * HTB, NXCD = 8, WGM = 8;

__host__ __device__ __forceinline__ int lds_byte(int r, int c) { const int st = (r >> 4) * 2 + (c >> 5), rr = r & 15, cc = c & 31, ob = rr * 64 + cc * 2; return st * 1024 + (ob ^ (((ob >> 9) & 1) << 5)); }
__host__ __device__ __forceinline__ void stage_rc(int b, int& R, int& C) { const int st = b / 1024, sb = b % 1024, swz = sb ^ (((sb >> 9) & 1) << 5); R = (st >> 1) * 16 + swz / 64; C = (st & 1) * 32 + (swz % 64) / 2; }
__host__ __device__ __forceinline__ int perm32(int rho) { const int n = rho >> 4, i = rho & 15; return 8 * (i >> 2) + 4 * n + (i & 3); }

struct Unit { int pm, pn; };
struct Gemm { const bf16_t* A; const bf16_t* Bt; int M, N, K, lda, ldb; };

struct StaticOrder {
    int nM, nN, nwg, G, c;
    __host__ __device__ void init(int M, int N, int G_, int c_) { nM = M / BM; nN = N / BM; nwg = nM * nN; G = G_; c = c_; }
    __host__ __device__ bool next(int i, Unit& u) const {
        const long L = (long)i * G + c; if (L >= nwg) return false;
        int wgid = (int)L; { const int q = nwg / NXCD, r = nwg % NXCD, xcd = wgid % NXCD, off = wgid / NXCD; wgid = (xcd < r ? xcd * (q + 1) : r * (q + 1) + (xcd - r) * q) + off; }
        const int nig = WGM * nN, gid = wgid / nig, fm = gid * WGM, gsz = (nM - fm) < WGM ? (nM - fm) : WGM;
        u.pm = fm + ((wgid % nig) % gsz); u.pn = (wgid % nig) / gsz; return true;
    }
    __device__ __forceinline__ void a_ready(const Unit&) const {}
    __device__ __forceinline__ void done(const Unit&) const {}
};
__device__ __forceinline__ unsigned cvt_pk_bf16(float lo, float hi) { unsigned r; asm volatile("v_cvt_pk_bf16_f32 %0, %1, %2" : "=v"(r) : "v"(lo), "v"(hi)); return r; }
struct EpiF32 {
    static constexpr bool PERM = false, AFTER_DRAIN = false;
    float* C; int ldc; const float* bias;
    __device__ __forceinline__ void operator()(const f32x4 (&acc)[2][2][4][2], const Unit& u, int wr, int wc, int fr, int fq) const {
        const int row0 = u.pm * BM + wr * 64 + fr, col0 = u.pn * BM + wc * 32 + 4 * fq;
        f32x4 bv[2][2];
#pragma unroll
        for (int bj = 0; bj < 2; ++bj)
#pragma unroll
            for (int n = 0; n < 2; ++n) bv[bj][n] = bias ? *(const f32x4*)(bias + col0 + bj * HALF + n * 16) : (f32x4){0.f, 0.f, 0.f, 0.f};
#pragma unroll
        for (int ai = 0; ai < 2; ++ai)
#pragma unroll
            for (int m = 0; m < 4; ++m) { float* rowp = C + (size_t)(row0 + ai * HALF + m * 16) * ldc + col0;
#pragma unroll
                for (int bj = 0; bj < 2; ++bj)
#pragma unroll
                    for (int n = 0; n < 2; ++n) *(f32x4*)(rowp + bj * HALF + n * 16) = acc[ai][bj][m][n] + bv[bj][n]; }
    }
};
typedef unsigned u32x2 __attribute__((ext_vector_type(2)));
__device__ __forceinline__ float sigm(float x) { return __builtin_amdgcn_rcpf(1.0f + __expf(-x)); }
__device__ __forceinline__ float silu_f(float x) { return x * sigm(x); }
__device__ __forceinline__ float bf2f(unsigned short b) { return __uint_as_float(((unsigned)b) << 16); }
__device__ __forceinline__ float bflo(unsigned w) { return __uint_as_float(w << 16); }
__device__ __forceinline__ float bfhi(unsigned w) { return __uint_as_float(w & 0xffff0000u); }
struct EpiBf16P {
    static constexpr bool PERM = true, AFTER_DRAIN = false;
    bf16_t* O; int ldc;
    __device__ __forceinline__ void operator()(const f32x4 (&acc)[2][2][4][2], const Unit& u, int wr, int wc, int fr, int fq) const {
        const int row0 = u.pm * BM + wr * 64 + fr, col0 = u.pn * BM + wc * 32 + 8 * fq;
#pragma unroll
        for (int ai = 0; ai < 2; ++ai)
#pragma unroll
            for (int m = 0; m < 4; ++m) { bf16_t* rowp = O + (size_t)(row0 + ai * HALF + m * 16) * ldc + col0;
#pragma unroll
                for (int bj = 0; bj < 2; ++bj) { const f32x4 v0 = acc[ai][bj][m][0], v1 = acc[ai][bj][m][1];
                    u32x4 w; w.x = cvt_pk_bf16(v0[0], v0[1]); w.y = cvt_pk_bf16(v0[2], v0[3]); w.z = cvt_pk_bf16(v1[0], v1[1]); w.w = cvt_pk_bf16(v1[2], v1[3]);
                    *(u32x4*)(rowp + bj * HALF) = w; } }
    }
};
struct EpiSwiglu {
    static constexpr bool PERM = true, AFTER_DRAIN = false;
    bf16_t* O; int ldc;
    __device__ __forceinline__ void operator()(const f32x4 (&acc)[2][2][4][2], const Unit& u, int wr, int wc, int fr, int fq) const {
        const int row0 = u.pm * BM + wr * 64 + fr, col0 = u.pn * HALF + wc * 32 + 8 * fq;
#pragma unroll
        for (int ai = 0; ai < 2; ++ai)
#pragma unroll
            for (int m = 0; m < 4; ++m) { bf16_t* rowp = O + (size_t)(row0 + ai * HALF + m * 16) * ldc + col0;
                const f32x4 g0 = acc[ai][0][m][0], g1 = acc[ai][0][m][1], u0 = acc[ai][1][m][0], u1 = acc[ai][1][m][1];
                float r[8];
#pragma unroll
                for (int j = 0; j < 4; ++j) { r[j] = silu_f(g0[j]) * u0[j]; r[4 + j] = silu_f(g1[j]) * u1[j]; }
                u32x4 w; w.x = cvt_pk_bf16(r[0], r[1]); w.y = cvt_pk_bf16(r[2], r[3]); w.z = cvt_pk_bf16(r[4], r[5]); w.w = cvt_pk_bf16(r[6], r[7]);
                *(u32x4*)rowp = w; }
    }
};
struct EpiGate1 {
    static constexpr bool PERM = true, AFTER_DRAIN = false;
    bf16_t* C; int ldc; const bf16_t* G; int ldg;
    __device__ __forceinline__ void operator()(const f32x4 (&acc)[2][2][4][2], const Unit& u, int wr, int wc, int fr, int fq) const {
        const int row0 = u.pm * BM + wr * 64 + fr, col0 = u.pn * BM + wc * 32 + 8 * fq;
#pragma unroll
        for (int ai = 0; ai < 2; ++ai)
#pragma unroll
            for (int m = 0; m < 4; ++m) { const size_t row = (size_t)(row0 + ai * HALF + m * 16);
#pragma unroll
                for (int bj = 0; bj < 2; ++bj) { const int col = col0 + bj * HALF;
                    const u32x4 gw = *(const u32x4*)(G + row * ldg + col);
                    const f32x4 v0 = acc[ai][bj][m][0], v1 = acc[ai][bj][m][1];
                    u32x4 w; w.x = cvt_pk_bf16(sigm(bflo(gw.x)) * v0[0], sigm(bfhi(gw.x)) * v0[1]); w.y = cvt_pk_bf16(sigm(bflo(gw.y)) * v0[2], sigm(bfhi(gw.y)) * v0[3]);
                    w.z = cvt_pk_bf16(sigm(bflo(gw.z)) * v1[0], sigm(bfhi(gw.z)) * v1[1]); w.w = cvt_pk_bf16(sigm(bflo(gw.w)) * v1[2], sigm(bfhi(gw.w)) * v1[3]);
                    *(u32x4*)(C + row * ldc + col) = w; } }
    }
};
struct EpiGate2 {
    static constexpr bool PERM = true, AFTER_DRAIN = false;
    bf16_t* O; int ldc; const bf16_t* T1; const bf16_t* G; int ldg;
    __device__ __forceinline__ void operator()(const f32x4 (&acc)[2][2][4][2], const Unit& u, int wr, int wc, int fr, int fq) const {
        const int row0 = u.pm * BM + wr * 64 + fr, col0 = u.pn * BM + wc * 32 + 8 * fq;
#pragma unroll
        for (int ai = 0; ai < 2; ++ai)
#pragma unroll
            for (int m = 0; m < 4; ++m) { const size_t row = (size_t)(row0 + ai * HALF + m * 16);
#pragma unroll
                for (int bj = 0; bj < 2; ++bj) { const int col = col0 + bj * HALF;
                    const u32x4 gw = *(const u32x4*)(G + row * ldg + col);
                    const u32x4 tw = *(const u32x4*)(T1 + row * ldc + col);
                    const f32x4 t0 = {bflo(tw.x), bfhi(tw.x), bflo(tw.y), bfhi(tw.y)}, t1 = {bflo(tw.z), bfhi(tw.z), bflo(tw.w), bfhi(tw.w)};
                    const f32x4 v0 = acc[ai][bj][m][0], v1 = acc[ai][bj][m][1];
                    float r[8];
                    r[0] = t0[0] + sigm(bflo(gw.x)) * v0[0]; r[1] = t0[1] + sigm(bfhi(gw.x)) * v0[1]; r[2] = t0[2] + sigm(bflo(gw.y)) * v0[2]; r[3] = t0[3] + sigm(bfhi(gw.y)) * v0[3];
                    r[4] = t1[0] + sigm(bflo(gw.z)) * v1[0]; r[5] = t1[1] + sigm(bfhi(gw.z)) * v1[1]; r[6] = t1[2] + sigm(bflo(gw.w)) * v1[2]; r[7] = t1[3] + sigm(bfhi(gw.w)) * v1[3];
                    u32x4 w; w.x = cvt_pk_bf16(r[0], r[1]); w.y = cvt_pk_bf16(r[2], r[3]); w.z = cvt_pk_bf16(r[4], r[5]); w.w = cvt_pk_bf16(r[6], r[7]);
                    *(u32x4*)(O + row * ldc + col) = w; } }
    }
};
template <class Epi, class Sched, bool ALIGN_EPI = false, bool SP2 = false>
__device__ __forceinline__ void gemm_phase(PG8_LAS unsigned char* lds, const Gemm g, const Sched& S, const Epi& E) {
    int tid_ = threadIdx.x; asm volatile("" : "+v"(tid_));
    const int tid = tid_, wid = __builtin_amdgcn_readfirstlane(tid >> 6), lane = tid & 63, wr = wid >> 2, wc = wid & 3, fr = lane & 15, fq = lane >> 4;
    const int K = g.K, nt = K / BK;
    unsigned voffA[2], voffB[2];
#pragma unroll
    for (int i = 0; i < 2; ++i) { int R, C; stage_rc(tid * 16 + i * 8192, R, C); const int Rb = Epi::PERM ? ((R & ~31) + perm32(R & 31)) : R;
        voffA[i] = (unsigned)(R * g.lda + C) * 2u; voffB[i] = (unsigned)(Rb * g.ldb + C) * 2u; }
    const size_t kstep = (size_t)(BK * 2);
    const size_t hstepA = (size_t)HALF * g.lda * 2, hstepB = (size_t)HALF * g.ldb * 2;
    const size_t tstepA = 2 * hstepA, tstepB = 2 * hstepB;
    const unsigned ldsw = (unsigned)wid * 1024u;
    const int aoff = lds_byte(wr * 64 + fr, fq * 8), boff = lds_byte(wc * 32 + fr, fq * 8);
#define PG8_SA(b, h) (((b) * 2 + (h)) * HTB)
#define PG8_SB(b, h) ((4 + (b) * 2 + (h)) * HTB)
#define PG8_STAGE(bufoff, gbase, voff) do { _Pragma("unroll") for (int _i = 0; _i < 2; ++_i) \
        __builtin_amdgcn_global_load_lds((const unsigned*)((const char*)(gbase) + (voff)[_i]), (PG8_LAS unsigned*)(lds + (bufoff) + ldsw + _i * 8192), 16, 0, 0); } while (0)
#define PG8_LDA(dst, b, h) do { _Pragma("unroll") for (int m = 0; m < 4; ++m) _Pragma("unroll") for (int k = 0; k < 2; ++k) dst[m][k] = *(const PG8_LAS bf16x8*)(lds + PG8_SA(b, h) + aoff + m * 2048 + k * 1024); } while (0)
#define PG8_LDB(dst, b, h) do { _Pragma("unroll") for (int n = 0; n < 2; ++n) _Pragma("unroll") for (int k = 0; k < 2; ++k) dst[n][k] = *(const PG8_LAS bf16x8*)(lds + PG8_SB(b, h) + boff + n * 2048 + k * 1024); } while (0)
#define PG8_MMA(ai, bj, At, Bt) do { __builtin_amdgcn_s_setprio(1); _Pragma("unroll") for (int m = 0; m < 4; ++m) _Pragma("unroll") for (int n = 0; n < 2; ++n) _Pragma("unroll") for (int k = 0; k < 2; ++k) \
        acc[ai][bj][m][n] = __builtin_amdgcn_mfma_f32_16x16x32_bf16(Bt[n][k], At[m][k], acc[ai][bj][m][n], 0, 0, 0); __builtin_amdgcn_s_setprio(0); } while (0)
#define PG8_WAIT_V(n) asm volatile("s_waitcnt vmcnt(" #n ")" ::: "memory")
#define PG8_WAIT_L(n) asm volatile("s_waitcnt lgkmcnt(" #n ")" ::: "memory")
#define PG8_BAR __builtin_amdgcn_s_barrier()
#define PG8_SCHED __builtin_amdgcn_sched_barrier(0)
    Unit cur, nxt; int ui = 0;
    if (!S.next(0, cur)) return;
    f32x4 acc[2][2][4][2];
#pragma unroll
    for (int a = 0; a < 2; ++a)
#pragma unroll
        for (int b = 0; b < 2; ++b)
#pragma unroll
            for (int m = 0; m < 4; ++m)
#pragma unroll
                for (int n = 0; n < 2; ++n) acc[a][b][m][n] = (f32x4){0.f, 0.f, 0.f, 0.f};
    bf16x8 At[4][2], B0[2][2], B1[2][2];
    const char* cA = (const char*)g.A + (size_t)cur.pm * tstepA; const char* cB = (const char*)g.Bt + (size_t)cur.pn * tstepB;
    S.a_ready(cur);
    if constexpr (SP2) {
        PG8_STAGE(PG8_SB(0, 0), cB, voffB); PG8_STAGE(PG8_SB(0, 1), cB + hstepB, voffB); PG8_STAGE(PG8_SA(0, 0), cA, voffA); PG8_STAGE(PG8_SA(0, 1), cA + hstepA, voffA);
        if (wr == 1) PG8_BAR;
        PG8_WAIT_V(2); PG8_BAR;
        PG8_STAGE(PG8_SB(1, 0), cB + kstep, voffB); PG8_STAGE(PG8_SA(1, 0), cA + kstep, voffA); PG8_STAGE(PG8_SB(1, 1), cB + hstepB + kstep, voffB);
        PG8_WAIT_V(6); PG8_BAR;
    } else {
        PG8_STAGE(PG8_SB(0, 0), cB, voffB); PG8_STAGE(PG8_SA(0, 0), cA, voffA); PG8_STAGE(PG8_SB(0, 1), cB + hstepB, voffB); PG8_STAGE(PG8_SA(0, 1), cA + hstepA, voffA);
        if (wr == 1) PG8_BAR;
        PG8_WAIT_V(4); PG8_BAR;
        PG8_STAGE(PG8_SB(1, 0), cB + kstep, voffB); PG8_STAGE(PG8_SA(1, 0), cA + kstep, voffA); PG8_STAGE(PG8_SB(1, 1), cB + hstepB + kstep, voffB);
        PG8_WAIT_V(6); PG8_BAR;
    }
    for (;;) {
        const bool has_next = S.next(ui + 1, nxt);
        const char* nA = has_next ? (const char*)g.A + (size_t)nxt.pm * tstepA : cA; const char* nB = has_next ? (const char*)g.Bt + (size_t)nxt.pn * tstepB : cB;
        for (int t = 0; t < nt; t += 2) {
            const bool last = (t == nt - 2);
            const char* a1 = cA + (size_t)(t + 1) * kstep;
            const char* a2 = last ? nA : cA + (size_t)(t + 2) * kstep; const char* b2 = last ? nB : cB + (size_t)(t + 2) * kstep;
            const char* a3 = a2 + kstep; const char* b3 = b2 + kstep;
            if (last && has_next) S.a_ready(nxt);
            if constexpr (SP2) {
            PG8_LDB(B0, 0, 0); PG8_LDB(B1, 0, 1); PG8_SCHED; PG8_LDA(At, 0, 0); PG8_STAGE(PG8_SA(1, 1), a1 + hstepA, voffA);
            PG8_WAIT_V(8); PG8_WAIT_L(0); PG8_BAR; PG8_MMA(0, 0, At, B0); PG8_MMA(0, 1, At, B1); PG8_BAR; PG8_SCHED;
            PG8_LDA(At, 0, 1); PG8_STAGE(PG8_SB(0, 0), b2, voffB); PG8_STAGE(PG8_SB(0, 1), b2 + hstepB, voffB); PG8_STAGE(PG8_SA(0, 0), a2, voffA);
            PG8_WAIT_V(8); PG8_WAIT_L(0); PG8_BAR; PG8_MMA(1, 0, At, B0); PG8_MMA(1, 1, At, B1); PG8_BAR; PG8_SCHED;
            PG8_LDB(B0, 1, 0); PG8_LDB(B1, 1, 1); PG8_SCHED; PG8_LDA(At, 1, 0); PG8_STAGE(PG8_SA(0, 1), a2 + hstepA, voffA);
            PG8_WAIT_V(8); PG8_WAIT_L(0); PG8_BAR; PG8_MMA(0, 0, At, B0); PG8_MMA(0, 1, At, B1); PG8_BAR; PG8_SCHED;
            PG8_LDA(At, 1, 1); PG8_STAGE(PG8_SB(1, 0), b3, voffB); PG8_STAGE(PG8_SB(1, 1), b3 + hstepB, voffB); PG8_STAGE(PG8_SA(1, 0), a3, voffA);
            PG8_WAIT_V(8); PG8_WAIT_L(0); PG8_BAR; PG8_MMA(1, 0, At, B0); PG8_MMA(1, 1, At, B1); PG8_BAR; PG8_SCHED;
            } else {
            PG8_LDB(B0, 0, 0); PG8_SCHED; PG8_LDA(At, 0, 0); PG8_STAGE(PG8_SA(1, 1), a1 + hstepA, voffA);
            PG8_WAIT_L(8); PG8_BAR; PG8_WAIT_L(0); PG8_MMA(0, 0, At, B0); PG8_BAR; PG8_SCHED;
            PG8_LDB(B1, 0, 1); PG8_STAGE(PG8_SB(0, 0), b2, voffB);
            PG8_BAR; PG8_WAIT_L(0); PG8_MMA(0, 1, At, B1); PG8_BAR;
            PG8_LDA(At, 0, 1); PG8_STAGE(PG8_SA(0, 0), a2, voffA);
            PG8_BAR; PG8_WAIT_L(0); PG8_MMA(1, 0, At, B0); PG8_BAR; PG8_SCHED;
            PG8_STAGE(PG8_SB(0, 1), b2 + hstepB, voffB);
            PG8_WAIT_V(6); PG8_BAR; PG8_MMA(1, 1, At, B1); PG8_BAR;
            PG8_LDB(B0, 1, 0); PG8_SCHED; PG8_LDA(At, 1, 0); PG8_STAGE(PG8_SA(0, 1), a2 + hstepA, voffA);
            PG8_WAIT_L(8); PG8_BAR; PG8_WAIT_L(0); PG8_MMA(0, 0, At, B0); PG8_BAR; PG8_SCHED;
            PG8_LDB(B1, 1, 1); PG8_STAGE(PG8_SB(1, 0), b3, voffB);
            PG8_BAR; PG8_WAIT_L(0); PG8_MMA(0, 1, At, B1); PG8_BAR;
            PG8_LDA(At, 1, 1); PG8_STAGE(PG8_SA(1, 0), a3, voffA);
            PG8_BAR; PG8_WAIT_L(0); PG8_MMA(1, 0, At, B0); PG8_BAR; PG8_SCHED;
            PG8_STAGE(PG8_SB(1, 1), b3 + hstepB, voffB);
            PG8_WAIT_V(6); PG8_BAR; PG8_MMA(1, 1, At, B1); PG8_BAR;
            }
        }
        if constexpr (ALIGN_EPI) { if (wr == 0) PG8_BAR; }
        if constexpr (!Epi::AFTER_DRAIN) { E(acc, cur, wr, wc, fr, fq); S.done(cur); }
        if (!has_next) break;
#pragma unroll
        for (int a = 0; a < 2; ++a)
#pragma unroll
            for (int b = 0; b < 2; ++b)
#pragma unroll
                for (int m = 0; m < 4; ++m)
#pragma unroll
                    for (int n = 0; n < 2; ++n) acc[a][b][m][n] = (f32x4){0.f, 0.f, 0.f, 0.f};
        cur = nxt; cA = nA; cB = nB; ++ui;
        if constexpr (ALIGN_EPI) { if (wr == 1) PG8_BAR; }
    }
    PG8_WAIT_V(0);
    if constexpr (!ALIGN_EPI) { if (wr == 0) PG8_BAR; }
    PG8_BAR;
    if constexpr (Epi::AFTER_DRAIN) { E.fused(acc, cur, wr, wc, fr, fq, lds, wid, lane); S.done(cur); }
#undef PG8_SA
#undef PG8_SB
#undef PG8_STAGE
#undef PG8_LDA
#undef PG8_LDB
#undef PG8_MMA
#undef PG8_WAIT_V
#undef PG8_WAIT_L
#undef PG8_BAR
#undef PG8_SCHED
}
}

using pg8::bf16_t; using pg8::bf16x8; using pg8::f32x4; using pg8::u32x4; using pg8::u32x2;
using pg8::sigm; using pg8::silu_f; using pg8::bf2f; using pg8::bflo; using pg8::bfhi;
#define LAS __attribute__((address_space(3)))
#define DI __device__ __forceinline__
typedef short s16x4 __attribute__((ext_vector_type(4)));
typedef float f32x2 __attribute__((ext_vector_type(2)));
typedef __bf16 bf2v __attribute__((ext_vector_type(2)));

constexpr int D = 2048, DFF = 5632, MT = 8704, MPR = 8192, DINP = 10496;
constexpr int C_Z = 3072, C_B = 4096, C_A = 4104, C_QM = 4112, C_CKV = 5648, C_KR = 6160, C_GG = 6224, C_GM = 8272;
constexpr size_t O_CONVP = 17825792, O_SSMP = 17844224, O_CKVP = 18106368, O_KRP = 22300672, O_CONVS = 22824960, O_SSMS = 22972416, O_CKVS = 25069568, O_KRS = 25331712;
constexpr size_t OFF_WIN = 0, OFF_WBRG = 42991616, OFF_WBRM = 47185920, OFF_WOUT = 51380224, OFF_WUK = 59768832, OFF_WUV = 60817408,
                 OFF_WGU = 61865984, OFF_WD = 108003328, OFF_XN = 131072000, OFF_QP = OFF_XN, OFF_CKVB = OFF_XN + 25165824, OFF_KRB = OFF_XN + 34078720,
                 OFF_R1 = 166723584, OFF_F = 349437952, OFF_GO = OFF_F, OFF_PO = OFF_F + 35651584, OFF_KV = 420741120, OFF_OM = 454295552, OFF_OG = 472121344,
                 OFF_QS = 489947136, OFF_ML = 494665728, OFF_CTL = 494796800, OFF_GP = 494800896, GP_STRIDE = 90368, WS_END = OFF_GP + 1152 * GP_STRIDE, OFF_BAR = WS_END, OFF_KCR = WS_END + 16384, OFF_KCC = OFF_WGU, WS_TOTAL = OFF_KCR + 8388608;
constexpr int LDS_BYTES = 155648, LDS_CTL = 155392;
constexpr float QSCALE = 0.10411754f;
constexpr float NEPS = 1e-6f;

struct Params { const float* in[29]; float* out; unsigned char* ws; };

DI unsigned pk2(float lo, float hi) { f32x2 v = {lo, hi}; bf2v b = __builtin_convertvector(v, bf2v); return __builtin_bit_cast(unsigned, b); }
DI unsigned short f2bf(float f) { __bf16 b = (__bf16)f; return __builtin_bit_cast(unsigned short, b); }
DI float wave_sum(float v) {
#pragma unroll
    for (int o = 32; o; o >>= 1) v += __shfl_xor(v, o);
    return v; }
DI f32x4 mfma16(bf16x8 a, bf16x8 b, f32x4 c) { return __builtin_amdgcn_mfma_f32_16x16x32_bf16(a, b, c, 0, 0, 0); }
DI s16x4 tr_read(const LAS bf16_t* p) { return __builtin_amdgcn_ds_read_tr16_b64_v4i16((LAS s16x4*)p); }
DI void unpack8(u32x4 w, float* x) { x[0] = bflo(w.x); x[1] = bfhi(w.x); x[2] = bflo(w.y); x[3] = bfhi(w.y); x[4] = bflo(w.z); x[5] = bfhi(w.z); x[6] = bflo(w.w); x[7] = bfhi(w.w); }
DI u32x4 pack8(const float* x) { u32x4 w; w.x = pk2(x[0], x[1]); w.y = pk2(x[2], x[3]); w.z = pk2(x[4], x[5]); w.w = pk2(x[6], x[7]); return w; }

struct TJ { const float* src; bf16_t* dst; int K, N, ldd, mode; };
template <class JOBFN>
DI void transpose_pass4(LAS float* tiles, const Params& p, int t0, JOBFN jobfn, int tid, bool& any) {
    TJ j[4]; int tk[4], tn[4]; bool ok[4];
#pragma unroll
    for (int u = 0; u < 4; ++u) ok[u] = jobfn(p, t0 + u, j[u], tk[u], tn[u]);
    any = ok[0];
    if (!any) return;
    const int r = tid >> 4, c4 = (tid & 15) * 4;
    float4 v0[4], v1[4];
#pragma unroll
    for (int u = 0; u < 4; ++u) { v0[u] = make_float4(0.f, 0.f, 0.f, 0.f); v1[u] = v0[u];
      if (ok[u] && tn[u] * 64 + c4 < j[u].N) { const float* s = j[u].src + (size_t)(tk[u] * 64 + r) * j[u].N + tn[u] * 64 + c4; const f32x4 t0 = __builtin_nontemporal_load((const f32x4*)s), t1 = __builtin_nontemporal_load((const f32x4*)(s + (size_t)32 * j[u].N)); v0[u] = make_float4(t0[0], t0[1], t0[2], t0[3]); v1[u] = make_float4(t1[0], t1[1], t1[2], t1[3]); } }
#pragma unroll
    for (int u = 0; u < 4; ++u) { LAS float* t0p = tiles + u * 4160 + r * 65 + c4; t0p[0] = v0[u].x; t0p[1] = v0[u].y; t0p[2] = v0[u].z; t0p[3] = v0[u].w;
      LAS float* t1p = t0p + 32 * 65; t1p[0] = v1[u].x; t1p[1] = v1[u].y; t1p[2] = v1[u].z; t1p[3] = v1[u].w; }
    __syncthreads();
    const int n = tid >> 3, k8 = (tid & 7) * 8;
#pragma unroll
    for (int u = 0; u < 4; ++u) { const int gn = tn[u] * 64 + n;
      if (ok[u] && gn < j[u].N) { float e[8];
#pragma unroll
        for (int q = 0; q < 8; ++q) e[q] = tiles[u * 4160 + (k8 + q) * 65 + n];
        const int drow = j[u].mode == 0 ? gn : ((gn >> 7) * 256 + (gn & 127) + (j[u].mode == 2 ? 128 : 0));
        *(u32x4*)(j[u].dst + (size_t)drow * j[u].ldd + tk[u] * 64 + k8) = pack8(e); } }
    __syncthreads();
}
#define TJOB(SRC, DST, K_, N_, MODE) { const int ntn = ((N_) + 63) / 64, nt = ((K_) / 64) * ntn; if (t < nt) { j.src = (SRC); j.dst = (bf16_t*)(DST); j.K = (K_); j.N = (N_); j.ldd = (K_); j.mode = (MODE); tk = t / ntn; tn = t % ntn; return true; } t -= nt; }
DI bool tjob_p0(const Params& p, int t, TJ& j, int& tk, int& tn) {
    unsigned char* ws = p.ws;
    TJOB(p.in[7], ws + OFF_WGU, 2048, 5632, 1)
    TJOB(p.in[8], ws + OFF_WGU, 2048, 5632, 2)
    TJOB(p.in[9], ws + OFF_WD, 5632, 2048, 0)
    return false;
}
DI bool tjob_win(const Params& p, int t, TJ& j, int& tk, int& tn) {
    unsigned char* ws = p.ws;
    TJOB(p.in[12], ws + OFF_WIN, 2048, 10320, 0)
    return false;
}
DI bool tjob_late(const Params& p, int t, TJ& j, int& tk, int& tn) {
    unsigned char* ws = p.ws;
    TJOB(p.in[18], ws + OFF_WUK, 512, 1024, 0)
    TJOB(p.in[19], ws + OFF_WUV, 512, 1024, 0)
    TJOB(p.in[20], ws + OFF_WBRG, 1024, 2048, 0)
    TJOB(p.in[21], ws + OFF_WBRM, 1024, 2048, 0)
    TJOB(p.in[22], ws + OFF_WOUT, 2048, 2048, 0)
    return false;
}
DI bool tjob_p3(const Params& p, int t, TJ& j, int& tk, int& tn) {
    unsigned char* ws = p.ws;
    TJOB(p.in[25], ws + OFF_WGU, 2048, 5632, 1)
    TJOB(p.in[26], ws + OFF_WGU, 2048, 5632, 2)
    TJOB(p.in[27], ws + OFF_WD, 5632, 2048, 0)
    return false;
}

template <bool HAS_F, bool W_Y, bool W_XN, bool RB = false, bool YB = false>
DI void rowop(const float* resid, const float* f, const bf16_t* fb, int nsum, float alpha, const float* gpost, const float* gnext, float* y, bf16_t* xn, int lane, const bf16_t* residb = nullptr, bf16_t* yb = nullptr) {
    float4 v[8];
#pragma unroll
    for (int i = 0; i < 8; ++i) { if (RB) { const u32x2 t = *(const u32x2*)(residb + (i * 64 + lane) * 4); v[i] = make_float4(bflo(t.x), bfhi(t.x), bflo(t.y), bfhi(t.y)); } else v[i] = *(const float4*)(resid + (i * 64 + lane) * 4); }
    if (HAS_F) {
        float4 fv[8]; float ss = 0.f;
        { const bf16_t* f0 = fb ? fb : (const bf16_t*)f;
#pragma unroll
          for (int i = 0; i < 8; ++i) { const u32x2 t = *(const u32x2*)(f0 + (i * 64 + lane) * 4); fv[i] = make_float4(bflo(t.x), bfhi(t.x), bflo(t.y), bfhi(t.y)); } }
#pragma unroll 1
        for (int s = 1; s < nsum; ++s) {
#pragma unroll
          for (int i = 0; i < 8; ++i) { const u32x2 t = *(const u32x2*)((const bf16_t*)f + (size_t)s * 512 * 2048 + (i * 64 + lane) * 4); fv[i].x += bflo(t.x); fv[i].y += bfhi(t.x); fv[i].z += bflo(t.y); fv[i].w += bfhi(t.y); } }
#pragma unroll
        for (int i = 0; i < 8; ++i) ss += fv[i].x * fv[i].x + fv[i].y * fv[i].y + fv[i].z * fv[i].z + fv[i].w * fv[i].w;
        ss = wave_sum(ss); const float rs = rsqrtf(ss * (1.0f / 2048.0f) + NEPS) * alpha;
#pragma unroll
        for (int i = 0; i < 8; ++i) { const float4 g = *(const float4*)(gpost + (i * 64 + lane) * 4);
            v[i].x += fv[i].x * rs * g.x; v[i].y += fv[i].y * rs * g.y; v[i].z += fv[i].z * rs * g.z; v[i].w += fv[i].w * rs * g.w; }
    }
    if (W_Y) {
#pragma unroll
        for (int i = 0; i < 8; ++i) { if (YB) { u32x2 w; w.x = pk2(v[i].x, v[i].y); w.y = pk2(v[i].z, v[i].w); *(u32x2*)(yb + (i * 64 + lane) * 4) = w; } else *(float4*)(y + (i * 64 + lane) * 4) = v[i]; }
    }
    if (W_XN) {
        float ss = 0.f;
#pragma unroll
        for (int i = 0; i < 8; ++i) ss += v[i].x * v[i].x + v[i].y * v[i].y + v[i].z * v[i].z + v[i].w * v[i].w;
        ss = wave_sum(ss); const float rs = rsqrtf(ss * (1.0f / 2048.0f) + NEPS);
#pragma unroll
        for (int i = 0; i < 8; ++i) { const float4 g = *(const float4*)(gnext + (i * 64 + lane) * 4);
            u32x2 w; w.x = pk2(v[i].x * rs * g.x, v[i].y * rs * g.y); w.y = pk2(v[i].z * rs * g.z, v[i].w * rs * g.w);
            *(u32x2*)(xn + (i * 64 + lane) * 4) = w; }
    }
}
DI const float* xin_row(const Params& p, int r) { return r < MPR ? p.in[0] + (size_t)r * D : p.in[1] + (size_t)(r - MPR) * D; }

DI void mla_prep_row(const Params& p, int r, int lane) {
    unsigned char* ws = p.ws;
    const bf16_t* pr = (const bf16_t*)(ws + OFF_R1) + (size_t)r * DINP;
    const bool samp = r >= MPR; const int rs = r - MPR; const int pos = samp ? 4096 + (rs & 31) : (r & 4095);
    { float x[8]; unpack8(*(const u32x4*)(pr + C_CKV + lane * 8), x);
      float ss = 0.f;
#pragma unroll
      for (int i = 0; i < 8; ++i) ss += x[i] * x[i];
      ss = wave_sum(ss); const float rn = rsqrtf(ss * (1.0f / 512.0f) + NEPS);
      const float4 g0 = *(const float4*)(p.in[17] + lane * 8), g1 = *(const float4*)(p.in[17] + lane * 8 + 4);
      x[0] *= rn * g0.x; x[1] *= rn * g0.y; x[2] *= rn * g0.z; x[3] *= rn * g0.w; x[4] *= rn * g1.x; x[5] *= rn * g1.y; x[6] *= rn * g1.z; x[7] *= rn * g1.w;
      float* o = p.out + (samp ? O_CKVS + (size_t)rs * 512 : O_CKVP + (size_t)r * 512) + lane * 8;
      *(float4*)o = make_float4(x[0], x[1], x[2], x[3]); *(float4*)(o + 4) = make_float4(x[4], x[5], x[6], x[7]);
      *(u32x4*)((bf16_t*)(ws + OFF_CKVB) + (size_t)r * 512 + lane * 8) = pack8(x); }
    const int i = lane & 31;
    const float inv = exp2f(-(float)i * 0.41524101186f); float rev = (float)pos * inv * 0.15915494309f; rev -= floorf(rev);
    const float sn = __builtin_amdgcn_sinf(rev), cs = __builtin_amdgcn_cosf(rev);
    if (lane < 32) { const float x1 = bf2f(pr[C_KR + i]), x2 = bf2f(pr[C_KR + 32 + i]);
      const float o1 = x1 * cs - x2 * sn, o2 = x2 * cs + x1 * sn;
      float* o = p.out + (samp ? O_KRS + (size_t)rs * 64 : O_KRP + (size_t)r * 64);
      o[i] = o1; o[32 + i] = o2;
      bf16_t* kb = (bf16_t*)(ws + OFF_KRB) + (size_t)r * 64; kb[i] = f2bf(o1); kb[32 + i] = f2bf(o2); }
#pragma unroll
    for (int hh = 0; hh < 4; ++hh) { const int h = hh * 2 + (lane >> 5);
      const float x1 = bf2f(pr[C_QM + h * 192 + 128 + i]), x2 = bf2f(pr[C_QM + h * 192 + 160 + i]);
      const float o1 = (x1 * cs - x2 * sn) * QSCALE, o2 = (x2 * cs + x1 * sn) * QSCALE;
      bf16_t* q = samp ? (bf16_t*)(ws + OFF_QS) + ((size_t)(((rs >> 5) * 8 + h) * 32 + (rs & 31))) * 576 + 512
                       : (bf16_t*)(ws + OFF_QP) + ((size_t)r * 8 + h) * 192 + 128;
      q[i] = f2bf(o1); q[32 + i] = f2bf(o2); }
    if (!samp) {
#pragma unroll
      for (int it = 0; it < 2; ++it) { const int idx = it * 512 + lane * 8, h = idx >> 7, d = idx & 127;
        float x[8]; unpack8(*(const u32x4*)(pr + C_QM + h * 192 + d), x);
#pragma unroll
        for (int q = 0; q < 8; ++q) x[q] *= QSCALE;
        *(u32x4*)((bf16_t*)(ws + OFF_QP) + ((size_t)r * 8 + h) * 192 + d) = pack8(x); } }
}

DI void qlat_item(const Params& p, int b, int h, int tid) {
    unsigned char* ws = p.ws;
    const int w = tid >> 6, lane = tid & 63, g = lane >> 4, c16 = lane & 15;
    bf16x8 qa[2][4];
#pragma unroll
    for (int mt = 0; mt < 2; ++mt)
#pragma unroll
      for (int ks = 0; ks < 4; ++ks) qa[mt][ks] = *(const bf16x8*)((const bf16_t*)(ws + OFF_R1) + (size_t)(MPR + b * 32 + 16 * mt + c16) * DINP + C_QM + h * 192 + 32 * ks + 8 * g);
    bf16_t* qo = (bf16_t*)(ws + OFF_QS) + (size_t)((b * 8 + h) * 32) * 576;
#pragma unroll
    for (int n4 = 0; n4 < 4; ++n4) { const int c = 16 * (4 * w + n4) + c16;
      const float* wp = p.in[18] + (size_t)c * 1024 + h * 128 + 8 * g;
      float4 wl[4][2];
#pragma unroll
      for (int ks = 0; ks < 4; ++ks) { wl[ks][0] = *(const float4*)(wp + 32 * ks); wl[ks][1] = *(const float4*)(wp + 32 * ks + 4); }
      f32x4 acc[2] = {(f32x4){0.f, 0.f, 0.f, 0.f}, (f32x4){0.f, 0.f, 0.f, 0.f}};
#pragma unroll
      for (int ks = 0; ks < 4; ++ks) { u32x4 pw; pw.x = pk2(wl[ks][0].x, wl[ks][0].y); pw.y = pk2(wl[ks][0].z, wl[ks][0].w); pw.z = pk2(wl[ks][1].x, wl[ks][1].y); pw.w = pk2(wl[ks][1].z, wl[ks][1].w);
        const bf16x8 wb = __builtin_bit_cast(bf16x8, pw);
#pragma unroll
        for (int mt = 0; mt < 2; ++mt) acc[mt] = mfma16(qa[mt][ks], wb, acc[mt]); }
#pragma unroll
      for (int mt = 0; mt < 2; ++mt)
#pragma unroll
        for (int j = 0; j < 4; ++j) qo[(size_t)(16 * mt + 4 * g + j) * 576 + c] = f2bf(acc[mt][j] * QSCALE); }
}
#define XB_TMO      128
#define XB_XCNT(j)  (256  + 64 * (j))
#define XB_XSUB(j)  (1280 + 64 * (j))
#define XB_XGEN(j)  (2304 + 64 * (j))
#define XB_TOP      3328
#define XB_TOPGEN   3392
#define XCD_BAR_WORDS 3456
#define XB_SPIN_CAP (1u << 18)

__device__ __forceinline__ unsigned xb_ld(unsigned* p)              { return __hip_atomic_load(p, __ATOMIC_RELAXED, __HIP_MEMORY_SCOPE_AGENT); }
__device__ __forceinline__ unsigned xb_add(unsigned* p, unsigned v) { return __hip_atomic_fetch_add(p, v, __ATOMIC_RELAXED, __HIP_MEMORY_SCOPE_AGENT); }
__device__ __forceinline__ unsigned xb_xcc_id() { return (unsigned)__builtin_amdgcn_s_getreg((3 << 11) | 20) & 0xFu; }
#define XB_SPIN(cond, bar) do { unsigned _sp = 0; while (cond) { __builtin_amdgcn_s_sleep(1); \
    if ((++_sp & 255u) == 0u) { if (xb_ld(&(bar)[XB_TMO])) break; if (_sp > XB_SPIN_CAP) { atomicAdd(&(bar)[XB_TMO], 1u); break; } } } } while (0)

struct XcdBarrier {
    unsigned* bar; unsigned x;
    volatile LAS unsigned* st;
};

__device__ __forceinline__ XcdBarrier xcd_barrier_post(unsigned* bar, volatile LAS unsigned* st) {
    XcdBarrier b; b.bar = bar; b.x = xb_xcc_id(); b.st = st;
    if (threadIdx.x == 0) (void)xb_add(&bar[XB_XCNT(b.x)], 1u);
    return b;
}
__device__ __forceinline__ void xcd_barrier_complete(unsigned* bar, unsigned x, unsigned& nloc, unsigned& nx) {
    const unsigned G = gridDim.x * gridDim.y * gridDim.z;
    unsigned sum, cnt, mine, sp = 0u;
    for (;;) {
        sum = 0u; cnt = 0u; mine = 0u;
#pragma unroll
        for (unsigned j = 0; j < 16; ++j) { const unsigned c = xb_ld(&bar[XB_XCNT(j)]); sum += c; cnt += (c > 0u) ? 1u : 0u; mine = (j == x) ? c : mine; }
        if (sum == G) break;
        __builtin_amdgcn_s_sleep(1);
        if ((++sp & 255u) == 0u) { if (xb_ld(&bar[XB_TMO])) break; if (sp > XB_SPIN_CAP) { atomicAdd(&bar[XB_TMO], 1u); break; } }
    }
    nloc = mine > 0u ? mine : 1u; nx = cnt > 0u ? cnt : 1u;
}

__device__ __forceinline__ void xcd_barrier(const XcdBarrier& b) {
    asm volatile("s_waitcnt vmcnt(0)" ::: "memory");
    __syncthreads();
    if (threadIdx.x == 0) {
        unsigned* bar = b.bar;
        __builtin_amdgcn_s_waitcnt(0);
        unsigned nloc = b.st[0], nx = b.st[1];
        if (nloc == 0u) { xcd_barrier_complete(bar, b.x, nloc, nx); b.st[0] = nloc; b.st[1] = nx; }
        const unsigned old = xb_add(&bar[XB_XSUB(b.x)], 1u);
        const unsigned gen = old / nloc;
        if (old + 1u == (gen + 1u) * nloc) {
            __builtin_amdgcn_fence(__ATOMIC_RELEASE, "agent");
            asm volatile("s_waitcnt vmcnt(0)" ::: "memory");
            const unsigned og = xb_add(&bar[XB_TOP], 1u);
            const unsigned tg = og / nx;
            if (og + 1u == (tg + 1u) * nx) xb_add(&bar[XB_TOPGEN], 1u);
            else XB_SPIN(xb_ld(&bar[XB_TOPGEN]) == tg, bar);
            __builtin_amdgcn_fence(__ATOMIC_ACQUIRE, "agent");
            xb_add(&bar[XB_XGEN(b.x)], 1u);
            asm volatile("s_waitcnt vmcnt(0)" ::: "memory");
        } else {
            XB_SPIN(xb_ld(&bar[XB_XGEN(b.x)]) == gen, bar);
            __builtin_amdgcn_fence(__ATOMIC_ACQUIRE, "agent");
            asm volatile("s_waitcnt vmcnt(0)" ::: "memory");
        }
    }
    __syncthreads();
}

DI void gdn_prep_item(const Params& p, int item, LAS unsigned char* lds, int tid) {
    unsigned char* ws = p.ws;
    int seq, ch, h; if (item < 1024) { seq = item >> 9; ch = (item >> 3) & 63; h = item & 7; } else { const int x = item - 1024; seq = 2 + (x >> 3); ch = 0; h = x & 7; }
    const bool samp = seq >= 2; const int ntok = samp ? 32 : 64;
    const int r0 = samp ? MPR + (seq - 2) * 32 : seq * 4096 + ch * 64;
    const bf16_t* proj = (const bf16_t*)(ws + OFF_R1);
    LAS bf16_t* sqb = (LAS bf16_t*)lds; LAS bf16_t* skb = sqb + 64 * 136;
    LAS float* sk = (LAS float*)(lds + 2 * 64 * 136 * 2); LAS float* sv = sk + 64 * 132; LAS float* sA = sv + 64 * 132;
    LAS float* s_gc = sA + 64 * 68; LAS float* s_beta = s_gc + 64; LAS float* s_eg = s_beta + 64; LAS float* sW = s_eg + 64;
    unsigned char* gp = ws + OFF_GP + (size_t)item * GP_STRIDE;
    { const int i = tid >> 3, dg = tid & 7;
#pragma unroll
      for (int which = 0; which < 3; ++which) { const int col = which * 1024 + h * 128 + dg * 16;
        float y[16];
#pragma unroll
        for (int c = 0; c < 16; ++c) y[c] = 0.f;
        if (i < ntok) {
#pragma unroll
          for (int jt = 0; jt < 4; ++jt) { const int tt = i - 3 + jt; float x[16];
            if (ch * 64 + tt >= 0) { const bf16_t* s = proj + (size_t)(r0 + tt) * DINP + col; unpack8(*(const u32x4*)s, x); unpack8(*(const u32x4*)(s + 8), x + 8); }
            else if (samp) { const float* s = p.in[2] + (size_t)((seq - 2) * 3 + 3 + tt) * 3072 + col;
#pragma unroll
              for (int c4 = 0; c4 < 4; ++c4) { const float4 v = *(const float4*)(s + c4 * 4); x[c4 * 4] = v.x; x[c4 * 4 + 1] = v.y; x[c4 * 4 + 2] = v.z; x[c4 * 4 + 3] = v.w; } }
            else {
#pragma unroll
              for (int c = 0; c < 16; ++c) x[c] = 0.f; }
            const float* wp = p.in[13] + jt * 3072 + col;
#pragma unroll
            for (int c4 = 0; c4 < 4; ++c4) { const float4 wv = *(const float4*)(wp + c4 * 4);
              y[c4 * 4] += x[c4 * 4] * wv.x; y[c4 * 4 + 1] += x[c4 * 4 + 1] * wv.y; y[c4 * 4 + 2] += x[c4 * 4 + 2] * wv.z; y[c4 * 4 + 3] += x[c4 * 4 + 3] * wv.w; } }
#pragma unroll
          for (int c = 0; c < 16; ++c) y[c] = silu_f(y[c]);
        }
        if (which < 2) { float ss = 0.f;
#pragma unroll
          for (int c = 0; c < 16; ++c) ss += y[c] * y[c];
          ss += __shfl_xor(ss, 1); ss += __shfl_xor(ss, 2); ss += __shfl_xor(ss, 4);
          const float sc = rsqrtf(ss + 1e-6f) * (which == 0 ? 0.08838834764f : 1.0f);
#pragma unroll
          for (int c = 0; c < 16; ++c) y[c] *= sc; }
        if (which > 0) { LAS float* dst = (which == 1 ? sk : sv) + i * 132 + dg * 16;
#pragma unroll
          for (int c4 = 0; c4 < 4; ++c4) *(LAS f32x4*)(dst + c4 * 4) = (f32x4){y[c4 * 4], y[c4 * 4 + 1], y[c4 * 4 + 2], y[c4 * 4 + 3]}; }
        if (which < 2) { LAS bf16_t* db = (which == 0 ? sqb : skb) + i * 136 + dg * 16; *(LAS u32x4*)db = pack8(y); *(LAS u32x4*)(db + 8) = pack8(y + 8); } } }
    if (tid < 64) { float g = 0.f, beta = 0.f;
      if (tid < ntok) { const bf16_t* s = proj + (size_t)(r0 + tid) * DINP; const float braw = bf2f(s[C_B + h]), araw = bf2f(s[C_A + h]);
        beta = 1.0f / (1.0f + expf(-braw)); const float xx = araw + p.in[15][h]; const float sp = xx > 20.f ? xx : log1pf(expf(xx)); g = -expf(p.in[14][h]) * sp; }
      float gc = g;
#pragma unroll
      for (int o = 1; o < 64; o <<= 1) { const float n = __shfl_up(gc, o); if (tid >= o) gc += n; }
      s_gc[tid] = gc; s_beta[tid] = beta; s_eg[tid] = expf(gc); }
    __syncthreads();
    { const int w = tid >> 6, lane = tid & 63, g = lane >> 4, c16 = lane & 15;
      bf16_t* QKo = (bf16_t*)(gp + 81920);
#pragma unroll 1
      for (int jb = 0; jb < 4; ++jb) { const int job = w * 4 + jb, tile = job >> 1, type = job & 1, mt = tile >> 2, nt = tile & 3;
        f32x4 acc = {0.f, 0.f, 0.f, 0.f};
        if (mt >= nt) { const LAS bf16_t* ap = (type ? sqb : skb) + (16 * mt + c16) * 136 + 8 * g; const LAS bf16_t* bp = skb + (16 * nt + c16) * 136 + 8 * g;
#pragma unroll
          for (int ks = 0; ks < 4; ++ks) acc = mfma16(*(const LAS bf16x8*)(ap + 32 * ks), *(const LAS bf16x8*)(bp + 32 * ks), acc); }
        const int j = 16 * nt + c16; const float gj = s_gc[j];
#pragma unroll
        for (int jj = 0; jj < 4; ++jj) { const int i = 16 * mt + 4 * g + jj; const float dec = (i >= j) ? expf(s_gc[i] - gj) : 0.f;
          if (type == 0) sA[i * 68 + j] = (i > j) ? s_beta[i] * acc[jj] * dec : 0.f;
          else QKo[i * 64 + j] = f2bf(acc[jj] * dec); } } }
    __syncthreads();
    if (tid >= 256) { const int t2 = tid - 256; const float glast = s_gc[63];
      { const int i = t2 >> 2, d0 = (t2 & 3) * 32; const float e = s_eg[i];
#pragma unroll
        for (int c8 = 0; c8 < 4; ++c8) { float x[8];
          unpack8(*(const LAS u32x4*)(sqb + i * 136 + d0 + c8 * 8), x);
#pragma unroll
          for (int q = 0; q < 8; ++q) x[q] *= e;
          *(u32x4*)((bf16_t*)(gp + 49152) + i * 128 + d0 + c8 * 8) = pack8(x); } }
      { const int d = t2 >> 1, i0 = (t2 & 1) * 32;
#pragma unroll
        for (int c8 = 0; c8 < 4; ++c8) { float x[8];
#pragma unroll
          for (int q = 0; q < 8; ++q) { const int i = i0 + c8 * 8 + q; x[q] = sk[i * 132 + d] * expf(glast - s_gc[i]); }
          *(u32x4*)((bf16_t*)(gp + 65536) + d * 64 + i0 + c8 * 8) = pack8(x); } }
      if (t2 == 0) *(float*)(gp + 90112) = expf(glast); }
    else { const bool isW = tid >= 128; const int d = tid & 127; const LAS float* Xs = isW ? sk : sv; LAS float* X = isW ? sW : sv;
#pragma unroll 1
      for (int ib = 0; ib < (samp ? 4 : 8); ++ib) { float s[8];
#pragma unroll
        for (int r = 0; r < 8; ++r) { const int i = 8 * ib + r; s[r] = Xs[i * 132 + d] * s_beta[i] * (isW ? s_eg[i] : 1.0f); }
#pragma unroll 2
        for (int j4 = 0; j4 < 2 * ib; ++j4) { const float x0 = X[(4 * j4) * 132 + d], x1 = X[(4 * j4 + 1) * 132 + d], x2 = X[(4 * j4 + 2) * 132 + d], x3 = X[(4 * j4 + 3) * 132 + d];
#pragma unroll
          for (int r = 0; r < 8; ++r) { const f32x4 a = *(const LAS f32x4*)(sA + (8 * ib + r) * 68 + 4 * j4); s[r] -= a[0] * x0 + a[1] * x1 + a[2] * x2 + a[3] * x3; } }
#pragma unroll
        for (int r = 1; r < 8; ++r)
#pragma unroll
          for (int c = 0; c < r; ++c) s[r] -= sA[(8 * ib + r) * 68 + 8 * ib + c] * s[c];
#pragma unroll
        for (int r = 0; r < 8; ++r) X[(8 * ib + r) * 132 + d] = s[r]; }
      if (samp && isW) {
#pragma unroll 1
        for (int i = 32; i < 64; ++i) X[i * 132 + d] = 0.f; } }
    __syncthreads();
    { const int i = tid >> 3, d0 = (tid & 7) * 16;
#pragma unroll
      for (int c4 = 0; c4 < 4; ++c4) *(f32x4*)((float*)gp + i * 128 + d0 + c4 * 4) = *(const LAS f32x4*)(sv + i * 132 + d0 + c4 * 4);
#pragma unroll
      for (int c8 = 0; c8 < 2; ++c8) { float x[8];
#pragma unroll
        for (int q = 0; q < 8; ++q) x[q] = -sW[i * 132 + d0 + c8 * 8 + q];
        *(u32x4*)((bf16_t*)(gp + 32768) + i * 128 + d0 + c8 * 8) = pack8(x); } }
    __syncthreads();
}

#define LDS_BARRIER() do { asm volatile("s_waitcnt lgkmcnt(0)" ::: "memory"); __builtin_amdgcn_s_barrier(); asm volatile("" ::: "memory"); } while (0)
#ifndef REP_SCAN
#define REP_SCAN 1
#endif
struct ScanOps { bf16x8 aw[4], aq[4], aqk[2], akd[2]; f32x4 u; float eg; };
DI void scan_load(ScanOps& o, const unsigned char* gp, int w, int mt, int nt, int sl, int c16, int g) {
    const bf16_t* NW = (const bf16_t*)(gp + 32768); const bf16_t* QG = (const bf16_t*)(gp + 49152); const bf16_t* KDT = (const bf16_t*)(gp + 65536); const bf16_t* QK = (const bf16_t*)(gp + 81920);
#pragma unroll
    for (int ks = 0; ks < 4; ++ks) { o.aw[ks] = *(const bf16x8*)(NW + (16 * mt + c16) * 128 + 32 * ks + 8 * g); o.aq[ks] = *(const bf16x8*)(QG + (16 * mt + c16) * 128 + 32 * ks + 8 * g); }
#pragma unroll
    for (int ks = 0; ks < 2; ++ks) { o.aqk[ks] = *(const bf16x8*)(QK + (16 * mt + c16) * 64 + 32 * ks + 8 * g); o.akd[ks] = *(const bf16x8*)(KDT + (16 * w + c16) * 64 + 32 * ks + 8 * g); }
    const float* U = (const float*)gp + sl * 32 + 16 * nt + c16;
#pragma unroll
    for (int j = 0; j < 4; ++j) o.u[j] = U[(16 * mt + 4 * g + j) * 128];
    o.eg = *(const float*)(gp + 90112);
}
DI void scan_item(const Params& p, int sitem, LAS unsigned char* lds, int tid) {
    unsigned char* ws = p.ws;
    int seq, h, sl, nch; if (sitem < 64) { seq = sitem >> 5; h = (sitem >> 2) & 7; sl = sitem & 3; nch = 64; } else { const int x = sitem - 64; seq = 2 + (x >> 5); h = (x >> 2) & 7; sl = x & 3; nch = 1; }
    const bool samp = seq >= 2; const int ntok = samp ? 32 : 64;
    LAS bf16_t* St = (LAS bf16_t*)lds; LAS bf16_t* Vn = St + 32 * 136;
    const int w = tid >> 6, lane = tid & 63, g = lane >> 4, c16 = lane & 15, mt = w & 3, nt = w >> 2;
    f32x4 Sacc[2];
#pragma unroll
    for (int n2 = 0; n2 < 2; ++n2)
#pragma unroll
      for (int j = 0; j < 4; ++j) Sacc[n2][j] = samp ? p.in[3][((size_t)((seq - 2) * 8 + h) * 128 + 16 * w + 4 * g + j) * 128 + sl * 32 + 16 * n2 + c16] : 0.f;
#pragma unroll
    for (int n2 = 0; n2 < 2; ++n2) { u32x2 pw; pw.x = pk2(Sacc[n2][0], Sacc[n2][1]); pw.y = pk2(Sacc[n2][2], Sacc[n2][3]); *(LAS u32x2*)(St + (16 * n2 + c16) * 136 + 16 * w + 4 * g) = pw; }
    const int gitem0 = samp ? 1024 + (seq - 2) * 8 + h : (seq * 64) * 8 + h;
    const unsigned char* gp0 = ws + OFF_GP + (size_t)gitem0 * GP_STRIDE;
    ScanOps ring[3];
    scan_load(ring[0], gp0, w, mt, nt, sl, c16, g);
    scan_load(ring[1], gp0 + (size_t)(nch > 1 ? 8 : 0) * GP_STRIDE, w, mt, nt, sl, c16, g);
    __syncthreads();
    bf16_t* GO = (bf16_t*)(ws + OFF_GO);
#define SCAN_STEP(CUR, NXT2, ch_) do { const int ch = (ch_); \
      scan_load(ring[NXT2], gp0 + (size_t)(ch + 2 < nch ? ch + 2 : nch - 1) * 8 * GP_STRIDE, w, mt, nt, sl, c16, g);     \
      const int r0 = samp ? MPR + (seq - 2) * 32 : seq * 4096 + ch * 64; \
      f32x4 vacc = ring[CUR].u, oacc = {0.f, 0.f, 0.f, 0.f}; \
      _Pragma("unroll") for (int ks = 0; ks < 4; ++ks) { const bf16x8 bs = *(const LAS bf16x8*)(St + (16 * nt + c16) * 136 + 32 * ks + 8 * g); vacc = mfma16(ring[CUR].aw[ks], bs, vacc); oacc = mfma16(ring[CUR].aq[ks], bs, oacc); } \
      { u32x2 pw; pw.x = pk2(vacc[0], vacc[1]); pw.y = pk2(vacc[2], vacc[3]); *(LAS u32x2*)(Vn + (16 * nt + c16) * 72 + 16 * mt + 4 * g) = pw; } \
      LDS_BARRIER(); \
      _Pragma("unroll") for (int ks = 0; ks < 2; ++ks) { const bf16x8 bv = *(const LAS bf16x8*)(Vn + (16 * nt + c16) * 72 + 32 * ks + 8 * g); oacc = mfma16(ring[CUR].aqk[ks], bv, oacc); } \
      _Pragma("unroll") for (int j = 0; j < 4; ++j) { const int c = 16 * mt + 4 * g + j; if (c < ntok) GO[(size_t)(r0 + c) * 1024 + h * 128 + sl * 32 + 16 * nt + c16] = f2bf(oacc[j]); } \
      _Pragma("unroll") for (int n2 = 0; n2 < 2; ++n2) { Sacc[n2] *= ring[CUR].eg; \
        _Pragma("unroll") for (int ks = 0; ks < 2; ++ks) { const bf16x8 bv = *(const LAS bf16x8*)(Vn + (16 * n2 + c16) * 72 + 32 * ks + 8 * g); Sacc[n2] = mfma16(ring[CUR].akd[ks], bv, Sacc[n2]); } \
        u32x2 pw; pw.x = pk2(Sacc[n2][0], Sacc[n2][1]); pw.y = pk2(Sacc[n2][2], Sacc[n2][3]); *(LAS u32x2*)(St + (16 * n2 + c16) * 136 + 16 * w + 4 * g) = pw; } \
      LDS_BARRIER(); } while (0)
    int ch3 = 0;
    for (; ch3 + 3 <= nch; ch3 += 3) { SCAN_STEP(0, 2, ch3); SCAN_STEP(1, 0, ch3 + 1); SCAN_STEP(2, 1, ch3 + 2); }
    if (ch3 < nch) SCAN_STEP(0, 2, ch3);
    if (ch3 + 1 < nch) SCAN_STEP(1, 0, ch3 + 1);
#undef SCAN_STEP
    float* So = p.out + (samp ? O_SSMS + (size_t)((seq - 2) * 8 + h) * 16384 : O_SSMP + (size_t)(seq * 8 + h) * 16384);
#pragma unroll
    for (int n2 = 0; n2 < 2; ++n2)
#pragma unroll
      for (int j = 0; j < 4; ++j) So[(size_t)(16 * w + 4 * g + j) * 128 + sl * 32 + 16 * n2 + c16] = Sacc[n2][j];
}
DI void pattn_item(const Params& p, int item, LAS unsigned char* lds, int tid) {
    unsigned char* ws = p.ws;
    const int qt = 15 - (item >> 4), b = (item >> 3) & 1, h = item & 7;
    const int w = tid >> 6, lane = tid & 63, g = lane >> 4, c16 = lane & 15;
    const int cq = 4 * qt + (w >> 1), nkt = 4 * qt + 4;
    LAS bf16_t* Kt = (LAS bf16_t*)lds;
    LAS bf16_t* Vt = Kt + 2 * 64 * 200;
    const bf16_t* KV = (const bf16_t*)(ws + OFF_KV) + (size_t)(b * 4096) * 2048 + h * 128;
    const bf16_t* KR = (const bf16_t*)(ws + OFF_KRB) + (size_t)(b * 4096) * 64;
    bf16x8 qf[2][6];
#pragma unroll
    for (int sb = 0; sb < 2; ++sb) { const bf16_t* q = (const bf16_t*)(ws + OFF_QP) + ((size_t)(b * 4096 + 256 * qt + 32 * w + 16 * sb + c16) * 8 + h) * 192 + 8 * g;
#pragma unroll
      for (int ks = 0; ks < 6; ++ks) qf[sb][ks] = *(const bf16x8*)(q + 32 * ks); }
    u32x4 ld[5];
    const int kr0 = tid >> 4, kc0 = (tid & 15) * 8;
    const int rr = tid >> 3, rc = (tid & 7) * 8;
#define PA_LOAD(kt) do { const size_t kb = (size_t)(kt) * 64; \
      ld[0] = *(const u32x4*)(KV + (kb + kr0) * 2048 + kc0); ld[1] = *(const u32x4*)(KV + (kb + kr0 + 32) * 2048 + kc0); \
      ld[2] = *(const u32x4*)(KV + (kb + kr0) * 2048 + 1024 + kc0); ld[3] = *(const u32x4*)(KV + (kb + kr0 + 32) * 2048 + 1024 + kc0); \
      ld[4] = *(const u32x4*)(KR + (kb + rr) * 64 + rc); } while (0)
#define PA_STORE(buf) do { LAS bf16_t* kd = Kt + (buf) * 64 * 200; LAS bf16_t* vd = Vt + (buf) * 64 * 144; \
      *(LAS u32x4*)(kd + kr0 * 200 + kc0) = ld[0]; *(LAS u32x4*)(kd + (kr0 + 32) * 200 + kc0) = ld[1]; \
      *(LAS u32x4*)(vd + kr0 * 144 + kc0) = ld[2]; *(LAS u32x4*)(vd + (kr0 + 32) * 144 + kc0) = ld[3]; \
      *(LAS u32x4*)(kd + rr * 200 + 128 + rc) = ld[4]; } while (0)
    PA_LOAD(0); PA_STORE(0);
    if (nkt > 1) PA_LOAD(1);
    __syncthreads();
    f32x4 oacc[2][8];
#pragma unroll
    for (int sb = 0; sb < 2; ++sb)
#pragma unroll
      for (int m = 0; m < 8; ++m) oacc[sb][m] = (f32x4){0.f, 0.f, 0.f, 0.f};
    float m_run[2] = {-1e30f, -1e30f}, l_run[2] = {0.f, 0.f};
    const int tq = c16 >> 2, tp = c16 & 3;
    for (int kt = 0; kt < nkt; ++kt) {
      const int buf = kt & 1;
      if (kt + 1 < nkt) { PA_STORE(buf ^ 1); if (kt + 2 < nkt) PA_LOAD(kt + 2); }
      if (kt <= cq) {
        const LAS bf16_t* kb = Kt + buf * 64 * 200; const LAS bf16_t* vb = Vt + buf * 64 * 144;
        f32x4 sacc[2][4];
#pragma unroll
        for (int t16 = 0; t16 < 4; ++t16) { bf16x8 kf[6];
#pragma unroll
          for (int ks = 0; ks < 6; ++ks) kf[ks] = *(const LAS bf16x8*)(kb + (16 * t16 + c16) * 200 + 32 * ks + 8 * g);
          sacc[0][t16] = (f32x4){0.f, 0.f, 0.f, 0.f}; sacc[1][t16] = (f32x4){0.f, 0.f, 0.f, 0.f};
#pragma unroll
          for (int ks = 0; ks < 6; ++ks) { sacc[0][t16] = mfma16(kf[ks], qf[0][ks], sacc[0][t16]); sacc[1][t16] = mfma16(kf[ks], qf[1][ks], sacc[1][t16]); } }
        bf16x8 pb[2][2];
#pragma unroll
        for (int sb = 0; sb < 2; ++sb) {
          float mx = sacc[sb][0][0];
#pragma unroll
          for (int t16 = 0; t16 < 4; ++t16)
#pragma unroll
            for (int j = 0; j < 4; ++j) mx = fmaxf(mx, sacc[sb][t16][j]);
          mx = fmaxf(mx, __shfl_xor(mx, 16)); mx = fmaxf(mx, __shfl_xor(mx, 32));
          const float mn = fmaxf(m_run[sb], mx), alpha = exp2f(m_run[sb] - mn); m_run[sb] = mn;
          float ps = 0.f;
#pragma unroll
          for (int t16 = 0; t16 < 4; ++t16)
#pragma unroll
            for (int j = 0; j < 4; ++j) { sacc[sb][t16][j] = exp2f(sacc[sb][t16][j] - mn); ps += sacc[sb][t16][j]; }
          l_run[sb] = l_run[sb] * alpha + ps;
#pragma unroll
          for (int m = 0; m < 8; ++m) oacc[sb][m] *= alpha;
#pragma unroll
          for (int s = 0; s < 2; ++s) { u32x4 pw; pw.x = pk2(sacc[sb][2 * s][0], sacc[sb][2 * s][1]); pw.y = pk2(sacc[sb][2 * s][2], sacc[sb][2 * s][3]); pw.z = pk2(sacc[sb][2 * s + 1][0], sacc[sb][2 * s + 1][1]); pw.w = pk2(sacc[sb][2 * s + 1][2], sacc[sb][2 * s + 1][3]);
            pb[sb][s] = __builtin_bit_cast(bf16x8, pw); } }
#pragma unroll
        for (int s = 0; s < 2; ++s)
#pragma unroll
          for (int mh = 0; mh < 2; ++mh) { s16x4 vf[4][2];
#pragma unroll
            for (int m4 = 0; m4 < 4; ++m4) { const int m = 4 * mh + m4; vf[m4][0] = tr_read(vb + (32 * s + 4 * g + tq) * 144 + 16 * m + 4 * tp); vf[m4][1] = tr_read(vb + (32 * s + 16 + 4 * g + tq) * 144 + 16 * m + 4 * tp); }
#pragma unroll
            for (int m4 = 0; m4 < 4; ++m4) { const int m = 4 * mh + m4; const bf16x8 va = __builtin_shufflevector(vf[m4][0], vf[m4][1], 0, 1, 2, 3, 4, 5, 6, 7);
              oacc[0][m] = mfma16(va, pb[0][s], oacc[0][m]); oacc[1][m] = mfma16(va, pb[1][s], oacc[1][m]); } }
      }
      __syncthreads();
    }
#undef PA_LOAD
#undef PA_STORE
#pragma unroll
    for (int sb = 0; sb < 2; ++sb) { float l = l_run[sb]; l += __shfl_xor(l, 16); l += __shfl_xor(l, 32);
      const float il = 1.0f / l;
      bf16_t* o = (bf16_t*)(ws + OFF_OM) + (size_t)(b * 4096 + 256 * qt + 32 * w + 16 * sb + c16) * 1024 + h * 128 + 4 * g;
#pragma unroll
      for (int m = 0; m < 8; ++m) { u32x2 pw; pw.x = pk2(oacc[sb][m][0] * il, oacc[sb][m][1] * il); pw.y = pk2(oacc[sb][m][2] * il, oacc[sb][m][3] * il); *(u32x2*)(o + 16 * m) = pw; } }
}

DI void sattn_item(const Params& p, int item, LAS unsigned char* lds, int tid) {
    unsigned char* ws = p.ws;
    const int b = item >> 4, hg = (item >> 2) & 3, sp = item & 3;
    const int w = tid >> 6, lane = tid & 63, g = lane >> 4, c16 = lane & 15, qs = w & 3, dh = w >> 2;
    LAS bf16_t* Qs = (LAS bf16_t*)lds;
    LAS bf16_t* Kt = Qs + 64 * 584;
    const int t_lo = sp * 32, t_hi = sp == 3 ? 129 : sp * 32 + 32;
    const float* ck = p.in[4] + (size_t)b * 4096 * 512; const float* kr = p.in[5] + (size_t)b * 4096 * 64;
    const bf16_t* ckn = (const bf16_t*)(ws + OFF_CKVB) + (size_t)(MPR + b * 32) * 512; const bf16_t* krn = (const bf16_t*)(ws + OFF_KRB) + (size_t)(MPR + b * 32) * 64;
    { const bf16_t* q0 = (const bf16_t*)(ws + OFF_QS) + (size_t)(b * 8 + 2 * hg) * 32 * 576;
      const int row = tid >> 3, c = tid & 7;
#pragma unroll
      for (int i = 0; i < 9; ++i) *(LAS u32x4*)(Qs + row * 584 + (c + 8 * i) * 8) = *(const u32x4*)(q0 + (size_t)row * 576 + (c + 8 * i) * 8); }
    float4 ld[9];
    const int lk = tid >> 7, lc = tid & 127, rk = tid >> 4, rc4 = tid & 15;
#define SA_LOAD(tile) do { if ((tile) < 128) { const float* s_ = ck + (size_t)((tile) * 32 + lk) * 512 + lc * 4; \
        _Pragma("unroll") for (int i = 0; i < 8; ++i) { const f32x4 t_ = __builtin_nontemporal_load((const f32x4*)(s_ + i * 2048)); ld[i] = make_float4(t_[0], t_[1], t_[2], t_[3]); } \
        { const f32x4 t_ = __builtin_nontemporal_load((const f32x4*)(kr + (size_t)((tile) * 32 + rk) * 64 + rc4 * 4)); ld[8] = make_float4(t_[0], t_[1], t_[2], t_[3]); } } \
      else { const bf16_t* s_ = ckn + lk * 512 + lc * 4; \
        _Pragma("unroll") for (int i = 0; i < 8; ++i) { const u32x2 v = *(const u32x2*)(s_ + i * 2048); ld[i] = make_float4(bflo(v.x), bfhi(v.x), bflo(v.y), bfhi(v.y)); } \
        const u32x2 v = *(const u32x2*)(krn + rk * 64 + rc4 * 4); ld[8] = make_float4(bflo(v.x), bfhi(v.x), bflo(v.y), bfhi(v.y)); } } while (0)
#define SA_STORE(buf) do { LAS bf16_t* kd = Kt + (buf) * 32 * 584; \
        _Pragma("unroll") for (int i = 0; i < 8; ++i) { u32x2 v; v.x = pk2(ld[i].x, ld[i].y); v.y = pk2(ld[i].z, ld[i].w); *(LAS u32x2*)(kd + (lk + 4 * i) * 584 + lc * 4) = v; } \
        { u32x2 v; v.x = pk2(ld[8].x, ld[8].y); v.y = pk2(ld[8].z, ld[8].w); *(LAS u32x2*)(kd + rk * 584 + 512 + rc4 * 4) = v; } } while (0)
    SA_LOAD(t_lo); SA_STORE(0);
    SA_LOAD(t_lo + 1);
    __syncthreads();
    f32x4 oacc[16];
#pragma unroll
    for (int m = 0; m < 16; ++m) oacc[m] = (f32x4){0.f, 0.f, 0.f, 0.f};
    float m_run = -1e30f, l_run = 0.f;
    const int tq = c16 >> 2, tp = c16 & 3;
    for (int tile = t_lo; tile < t_hi; ++tile) {
      const int buf = (tile - t_lo) & 1;
      if (tile + 1 < t_hi) { SA_STORE(buf ^ 1); if (tile + 2 < t_hi) SA_LOAD(tile + 2); }
      const LAS bf16_t* kb = Kt + buf * 32 * 584;
      f32x4 sacc[2] = {(f32x4){0.f, 0.f, 0.f, 0.f}, (f32x4){0.f, 0.f, 0.f, 0.f}};
      bf16x8 fr[2][2][3];
#define SA_FRAGS(dst, grp) do { _Pragma("unroll") for (int k6 = 0; k6 < 2; ++k6) { const int ks = (grp) * 2 + k6; \
        dst[k6][0] = *(const LAS bf16x8*)(Qs + (16 * qs + c16) * 584 + 32 * ks + 8 * g); \
        dst[k6][1] = *(const LAS bf16x8*)(kb + c16 * 584 + 32 * ks + 8 * g); dst[k6][2] = *(const LAS bf16x8*)(kb + (16 + c16) * 584 + 32 * ks + 8 * g); } } while (0)
      SA_FRAGS(fr[0], 0);
#pragma unroll
      for (int grp = 0; grp < 9; ++grp) {
        if (grp < 8) SA_FRAGS(fr[(grp + 1) & 1], grp + 1);
        __builtin_amdgcn_sched_barrier(0);
#pragma unroll
        for (int k6 = 0; k6 < 2; ++k6) { sacc[0] = mfma16(fr[grp & 1][k6][1], fr[grp & 1][k6][0], sacc[0]); sacc[1] = mfma16(fr[grp & 1][k6][2], fr[grp & 1][k6][0], sacc[1]); }
        __builtin_amdgcn_sched_barrier(0); }
#undef SA_FRAGS
      float mx = sacc[0][0];
#pragma unroll
      for (int t16 = 0; t16 < 2; ++t16)
#pragma unroll
        for (int j = 0; j < 4; ++j) mx = fmaxf(mx, sacc[t16][j]);
      mx = fmaxf(mx, __shfl_xor(mx, 16)); mx = fmaxf(mx, __shfl_xor(mx, 32));
      const float mn = fmaxf(m_run, mx), alpha = exp2f(m_run - mn); m_run = mn;
      float ps = 0.f;
#pragma unroll
      for (int t16 = 0; t16 < 2; ++t16)
#pragma unroll
        for (int j = 0; j < 4; ++j) { sacc[t16][j] = exp2f(sacc[t16][j] - mn); ps += sacc[t16][j]; }
      l_run = l_run * alpha + ps;
      u32x4 pw; pw.x = pk2(sacc[0][0], sacc[0][1]); pw.y = pk2(sacc[0][2], sacc[0][3]); pw.z = pk2(sacc[1][0], sacc[1][1]); pw.w = pk2(sacc[1][2], sacc[1][3]);
      const bf16x8 pb = __builtin_bit_cast(bf16x8, pw);
      s16x4 vf[2][4][2];
#define SA_VF(dst, q4) do { _Pragma("unroll") for (int m = 0; m < 4; ++m) { dst[m][0] = tr_read(kb + (4 * g + tq) * 584 + 256 * dh + 16 * (4 * (q4) + m) + 4 * tp); \
        dst[m][1] = tr_read(kb + (16 + 4 * g + tq) * 584 + 256 * dh + 16 * (4 * (q4) + m) + 4 * tp); } } while (0)
      SA_VF(vf[0], 0);
#pragma unroll
      for (int q4 = 0; q4 < 4; ++q4) {
        if (q4 < 3) SA_VF(vf[(q4 + 1) & 1], q4 + 1);
#pragma unroll
        for (int m = 0; m < 4; ++m) oacc[4 * q4 + m] *= alpha;
        __builtin_amdgcn_sched_barrier(0);
#pragma unroll
        for (int m = 0; m < 4; ++m) { const bf16x8 va = __builtin_shufflevector(vf[q4 & 1][m][0], vf[q4 & 1][m][1], 0, 1, 2, 3, 4, 5, 6, 7); oacc[4 * q4 + m] = mfma16(va, pb, oacc[4 * q4 + m]); }
        __builtin_amdgcn_sched_barrier(0); }
#undef SA_VF
      __syncthreads();
    }
#undef SA_LOAD
#undef SA_STORE
    l_run += __shfl_xor(l_run, 16); l_run += __shfl_xor(l_run, 32);
    const int qrow = 16 * qs + c16, h = 2 * hg + (qrow >> 5), t = qrow & 31;
    const size_t prow = (size_t)((b * 8 + h) * 4 + sp) * 32 + t;
    bf16_t* po = (bf16_t*)(ws + OFF_PO) + prow * 512 + 256 * dh + 4 * g;
#pragma unroll
    for (int m = 0; m < 16; ++m) { u32x2 pw; pw.x = pk2(oacc[m][0], oacc[m][1]); pw.y = pk2(oacc[m][2], oacc[m][3]); *(u32x2*)(po + 16 * m) = pw; }
    if (dh == 0 && g == 0) { float* ml = (float*)(ws + OFF_ML) + prow * 2; ml[0] = m_run; ml[1] = l_run; }
}

DI void og_row(const Params& p, int r, int lane) {
    unsigned char* ws = p.ws;
    const bf16_t* o = (const bf16_t*)(ws + OFF_GO) + (size_t)r * 1024 + lane * 16;
    float x[16]; unpack8(*(const u32x4*)o, x); unpack8(*(const u32x4*)(o + 8), x + 8);
    float ss = 0.f;
#pragma unroll
    for (int c = 0; c < 16; ++c) ss += x[c] * x[c];
    ss += __shfl_xor(ss, 1); ss += __shfl_xor(ss, 2); ss += __shfl_xor(ss, 4);
    const float rn = rsqrtf(ss * (1.0f / 128.0f) + NEPS);
    const bf16_t* z = (const bf16_t*)(ws + OFF_R1) + (size_t)r * DINP + C_Z + lane * 16;
    float zz[16]; unpack8(*(const u32x4*)z, zz); unpack8(*(const u32x4*)(z + 8), zz + 8);
    const float* gw = p.in[16] + (lane & 7) * 16;
#pragma unroll
    for (int c = 0; c < 16; ++c) x[c] = x[c] * rn * gw[c] * silu_f(zz[c]);
    bf16_t* og = (bf16_t*)(ws + OFF_OG) + (size_t)r * 1024 + lane * 16;
    *(u32x4*)og = pack8(x); *(u32x4*)(og + 8) = pack8(x + 8);
}
DI void scomb_item(const Params& p, int b, int h, LAS bf16_t* ol, int tid) {
    unsigned char* ws = p.ws;
    const bf16_t* PO = (const bf16_t*)(ws + OFF_PO) + (size_t)((b * 8 + h) * 4) * 32 * 512; const float* ML = (const float*)(ws + OFF_ML) + (size_t)((b * 8 + h) * 4) * 32 * 2;
#pragma unroll 4
    for (int t = 0; t < 32; ++t) { float m[4], l[4], mx = -1e30f;
#pragma unroll
      for (int s = 0; s < 4; ++s) { m[s] = ML[(s * 32 + t) * 2]; l[s] = ML[(s * 32 + t) * 2 + 1]; mx = fmaxf(mx, m[s]); }
      float L = 0.f, acc = 0.f;
#pragma unroll
      for (int s = 0; s < 4; ++s) { const float ws_ = exp2f(m[s] - mx); L += ws_ * l[s]; acc += ws_ * bf2f(PO[(size_t)(s * 32 + t) * 512 + tid]); }
      ol[t * 520 + tid] = f2bf(acc / L); }
    __syncthreads();
    const int w = tid >> 6, lane = tid & 63, g = lane >> 4, c16 = lane & 15;
    const bf16_t* wt = (const bf16_t*)(ws + OFF_WUV) + (size_t)(h * 128 + 16 * w + c16) * 512 + 8 * g;
    bf16x8 wb[16];
#pragma unroll
    for (int ks = 0; ks < 16; ++ks) wb[ks] = *(const bf16x8*)(wt + 32 * ks);
    f32x4 acc[2] = {(f32x4){0.f, 0.f, 0.f, 0.f}, (f32x4){0.f, 0.f, 0.f, 0.f}};
#pragma unroll
    for (int ks = 0; ks < 16; ++ks)
#pragma unroll
      for (int mt = 0; mt < 2; ++mt) { const bf16x8 a = *(const LAS bf16x8*)(ol + (16 * mt + c16) * 520 + 32 * ks + 8 * g); acc[mt] = mfma16(a, wb[ks], acc[mt]); }
    bf16_t* om = (bf16_t*)(ws + OFF_OM) + (size_t)(MPR + b * 32) * 1024 + h * 128 + 16 * w + c16;
#pragma unroll
    for (int mt = 0; mt < 2; ++mt)
#pragma unroll
      for (int j = 0; j < 4; ++j) om[(size_t)(16 * mt + 4 * g + j) * 1024] = f2bf(acc[mt][j]);
    __syncthreads();
}
#ifndef GEMM_SP2
#define GEMM_SP2 true
#endif
#ifndef GEMM_ALIGN
#define GEMM_ALIGN true
#endif
template <class Epi>
DI void run_gemm(LAS unsigned char* lds, const bf16_t* A, const bf16_t* Bt, int M, int N, int K, const Epi& E, int G, int c) {
    pg8::Gemm g{A, Bt, M, N, K, K, K}; pg8::StaticOrder S; S.init(M, N, G, c);
    pg8::gemm_phase<Epi, pg8::StaticOrder, GEMM_ALIGN, GEMM_SP2>((PG8_LAS unsigned char*)lds, g, S, E);
}
struct OneUnit { int pm, pn;
    DI bool next(int i, pg8::Unit& u) const { if (i) return false; u.pm = pm; u.pn = pn; return true; }
    DI void a_ready(const pg8::Unit&) const {}
    DI void done(const pg8::Unit&) const {} };
template <class Epi>
DI void run_gemm_split_e(LAS unsigned char* lds, const bf16_t* A, const bf16_t* Bt, int K, int ksub, const Epi& E, int c) {
    const int s = c >> 4, u = c & 15;
    pg8::Gemm g{A + (size_t)s * ksub, Bt + (size_t)s * ksub, MT, D, ksub, K, K}; OneUnit S{32 + (u >> 3), u & 7};
    pg8::gemm_phase<Epi, OneUnit, GEMM_ALIGN, GEMM_SP2>((PG8_LAS unsigned char*)lds, g, S, E);
}
DI void run_gemm_split(LAS unsigned char* lds, const bf16_t* A, const bf16_t* Bt, int K, int ksub, float* part, int c) {
    const int nsplit = K / ksub;
    if (c >= 16 * nsplit) return;
    pg8::EpiBf16P E{(bf16_t*)part + (size_t)(c >> 4) * 512 * D - (size_t)MPR * D, D};
    run_gemm_split_e(lds, A, Bt, K, ksub, E, c);
}
#ifndef REP_PREP
#define REP_PREP 1
#endif
#ifndef REP_SCAN
#define REP_SCAN 1
#endif
#ifndef REP_PATTN
#define REP_PATTN 1
#endif
#ifndef REP_SATTN
#define REP_SATTN 1
#endif
#ifndef REP_P0
#define REP_P0 1
#endif
#ifndef REP_P1
#define REP_P1 1
#endif
#ifndef REP_P5
#define REP_P5 1
#endif
#ifndef REP_P7
#define REP_P7 1
#endif
__global__ void __launch_bounds__(512, 2) fwd_megakernel(Params p) {
    extern __shared__ __attribute__((aligned(16))) unsigned char smem[];
    LAS unsigned char* lds = (LAS unsigned char*)smem;
    cg::grid_group grid = cg::this_grid();
    int tid = threadIdx.x, lane = tid & 63, wv = tid >> 6; const int G = gridDim.x, bid = blockIdx.x;
#define FRESH_TID() do { tid = threadIdx.x; asm volatile("" : "+v"(tid)); lane = tid & 63; wv = tid >> 6; } while (0)
    unsigned char* ws = p.ws;
    bf16_t* XN = (bf16_t*)(ws + OFF_XN); bf16_t* R1 = (bf16_t*)(ws + OFF_R1); float* F = (float*)(ws + OFF_F); float* Y = p.out;
    unsigned* ctl = (unsigned*)(ws + OFF_CTL); float* FP = (float*)(ws + OFF_KV); bf16_t* FB = (bf16_t*)(ws + OFF_F); bf16_t* XB2 = (bf16_t*)(ws + OFF_GP); bf16_t* XB1 = (bf16_t*)p.out;
    LAS int* s_item = (LAS int*)(lds + LDS_CTL);
    if (tid < 8) ((LAS unsigned*)(lds + LDS_CTL))[tid] = 0u;
    __syncthreads();
    if (p.out == nullptr) grid.sync();
    XcdBarrier xb = xcd_barrier_post((unsigned*)(ws + OFF_BAR), (volatile LAS unsigned*)(lds + LDS_CTL + 16));

#define DRAIN_TR() do { for (;;) { __syncthreads(); if (tid == 0) *s_item = (int)atomicAdd(ctl + 2, 1u); __syncthreads(); const int q_ = *s_item; if (q_ >= 2112) break; \
      bool any_; transpose_pass4((LAS float*)lds, p, q_ * 4, tjob_p3, tid, any_); } } while (0)
#define DRAIN_LATE() do { for (;;) { __syncthreads(); if (tid == 0) *s_item = (int)atomicAdd(ctl + 3, 1u); __syncthreads(); const int q_ = *s_item; if (q_ >= 640) break; \
      bool any_; transpose_pass4((LAS float*)lds, p, q_ * 4, tjob_late, tid, any_); } } while (0)
#define DRAIN_WIN() do { for (;;) { __syncthreads(); if (tid == 0) *s_item = (int)atomicAdd(ctl + 4, 1u); __syncthreads(); const int q_ = *s_item; if (q_ >= 1296) break; \
      bool any_; transpose_pass4((LAS float*)lds, p, q_ * 4, tjob_win, tid, any_); } } while (0)
    if (tid == 0) { const unsigned x = (unsigned)__builtin_amdgcn_s_getreg((3 << 11) | 20) & 0xFu; const unsigned slot = atomicAdd(ctl + 16 + (x & 7u), 1u); s_item[1] = (int)(slot * 8u + (x & 7u)); }
    for (int r = bid * 8 + wv; r < MT; r += G * 8) rowop<false, false, true>(xin_row(p, r), nullptr, nullptr, 0, 0.f, nullptr, p.in[6], nullptr, XN + (size_t)r * D, lane);
    _Pragma("unroll") for (int rep = 0; rep < REP_P0; ++rep) {
    for (int t = bid * 4;; t += G * 4) { bool any; transpose_pass4((LAS float*)lds, p, t, tjob_p0, tid, any); if (!any) break; }
    xcd_barrier(xb); FRESH_TID(); }
    int gid = bid;
    { bool ok = (G % 8) == 0;
      for (int x = 0; x < 8; ++x) ok = ok && (__hip_atomic_load(ctl + 16 + x, __ATOMIC_RELAXED, __HIP_MEMORY_SCOPE_AGENT) == (unsigned)(G / 8));
      if (ok) gid = s_item[1]; }
    gid = __builtin_amdgcn_readfirstlane(gid);
    _Pragma("unroll") for (int rep = 0; rep < REP_P1; ++rep) {
    { pg8::EpiSwiglu E{R1, DFF}; run_gemm(lds, XN, (const bf16_t*)(ws + OFF_WGU), MT, 2 * DFF, D, E, G, gid); }
    DRAIN_LATE(); DRAIN_WIN();
    xcd_barrier(xb); FRESH_TID(); }
    { pg8::EpiBf16P E{FB, D}; run_gemm(lds, R1, (const bf16_t*)(ws + OFF_WD), MPR, D, DFF, E, G, gid); }
    __syncthreads();
    run_gemm_split(lds, R1, (const bf16_t*)(ws + OFF_WD), DFF, 512, FP, G - 1 - gid);
    __syncthreads(); DRAIN_WIN();
    xcd_barrier(xb); FRESH_TID();
    for (int r = bid * 8 + wv; r < MT; r += G * 8) rowop<true, true, true, false, true>(xin_row(p, r), r < MPR ? nullptr : (const float*)((const bf16_t*)FP + (size_t)(r - MPR) * D), r < MPR ? FB + (size_t)r * D : nullptr, r < MPR ? 1 : 11, 0.5f, p.in[10], p.in[11], nullptr, XN + (size_t)r * D, lane, nullptr, XB1 + (size_t)r * D);
    DRAIN_WIN();
    xcd_barrier(xb); FRESH_TID();
    { pg8::EpiBf16P E{R1, DINP}; run_gemm(lds, XN, (const bf16_t*)(ws + OFF_WIN), MT, DINP, D, E, G, gid); }
    DRAIN_LATE();
    DRAIN_TR();
    xcd_barrier(xb); FRESH_TID();
    _Pragma("unroll") for (int rep = 0; rep < REP_P5; ++rep) {
    for (int r = bid * 8 + wv; r < MT; r += G * 8) mla_prep_row(p, r, lane);
    for (int i = bid * 512 + tid; i < 18 * 3 * 3072; i += G * 512) { const int seq = i / 9216, rem = i % 9216, jr = rem / 3072, c = rem % 3072;
        const int row = seq < 2 ? seq * 4096 + 4093 + jr : MPR + (seq - 2) * 32 + 29 + jr;
        const float v = bf2f(R1[(size_t)row * DINP + c]);
        if (seq < 2) Y[O_CONVP + (size_t)(seq * 3 + jr) * 3072 + c] = v; else Y[O_CONVS + (size_t)((seq - 2) * 3 + jr) * 3072 + c] = v; }
#ifndef SK_QLAT
    for (int it = bid; it < 128; it += G) qlat_item(p, it >> 3, it & 7, tid);
#endif
#ifndef SK_PREP
    for (int rp = 0; rp < REP_PREP; ++rp)
    for (int it = bid; it < 1152; it += G) gdn_prep_item(p, it, lds, tid);
#endif
    xcd_barrier(xb); FRESH_TID(); }
    { pg8::EpiBf16P E{(bf16_t*)(ws + OFF_KV), 2048}; run_gemm(lds, (const bf16_t*)(ws + OFF_CKVB), (const bf16_t*)(ws + OFF_WUK), MPR, 2048, 512, E, G, gid); }
    xcd_barrier(xb); FRESH_TID();
    _Pragma("unroll") for (int rep = 0; rep < REP_P7; ++rep) {
#define FETCH_ITEM() do { __syncthreads(); if (tid == 0) *s_item = (int)atomicAdd(ctl + rep, 1u); __syncthreads(); it = *s_item; } while (0)
    {
      for (int i0 = gid; i0 < 64; i0 += G) { const int sit = ((i0 & 7) + 8 * (i0 >> 5)) * 4 + ((i0 >> 3) & 3); scan_item(p, sit, lds, tid); __syncthreads(); }
      int it; FETCH_ITEM();
      while (it < 128) { pattn_item(p, it, lds, tid); FETCH_ITEM(); }
      while (it < 384) { sattn_item(p, it - 128, lds, tid); FETCH_ITEM(); }
      while (it < 512) { pattn_item(p, it - 384 + 128, lds, tid); FETCH_ITEM(); }
      while (it < 1024) { scan_item(p, 64 + (it - 512), lds, tid); FETCH_ITEM(); }
    }
    DRAIN_TR();
    xcd_barrier(xb); FRESH_TID(); }
    for (int r = bid * 8 + wv; r < MT; r += G * 8) og_row(p, r, lane);
#ifndef SK_SCOMB
    for (int it = bid; it < 128; it += G) scomb_item(p, it >> 3, it & 7, (LAS bf16_t*)lds, tid);
#endif
    xcd_barrier(xb); FRESH_TID();
    { pg8::EpiGate1 E{FB, D, R1 + C_GG, DINP}; run_gemm(lds, (const bf16_t*)(ws + OFF_OG), (const bf16_t*)(ws + OFF_WBRG), MPR, D, 1024, E, G, gid); }
    __syncthreads();
    { pg8::EpiGate2 E{XN, D, FB, R1 + C_GM, DINP}; run_gemm(lds, (const bf16_t*)(ws + OFF_OM), (const bf16_t*)(ws + OFF_WBRM), MPR, D, 1024, E, G, gid); }
    __syncthreads();
    { const int c = G - 1 - gid;
      if (c < 64) { pg8::EpiGate1 E{(bf16_t*)FP + (size_t)(c >> 4) * 512 * D - (size_t)MPR * D, D, R1 + C_GG, DINP}; run_gemm_split_e(lds, (const bf16_t*)(ws + OFF_OG), (const bf16_t*)(ws + OFF_WBRG), 1024, 256, E, c); }
      else if (c < 128) { const int c2 = c - 64; pg8::EpiGate1 E{(bf16_t*)FP + (size_t)(4 + (c2 >> 4)) * 512 * D - (size_t)MPR * D, D, R1 + C_GM, DINP}; run_gemm_split_e(lds, (const bf16_t*)(ws + OFF_OM), (const bf16_t*)(ws + OFF_WBRM), 1024, 256, E, c2); } }
    xcd_barrier(xb); FRESH_TID();
    for (int r = bid * 8 + wv; r < 512; r += G * 8) {
      float4 v[8]; const bf16_t* fpb = (const bf16_t*)FP + (size_t)r * D;
#pragma unroll
      for (int i = 0; i < 8; ++i) { const u32x2 t = *(const u32x2*)(fpb + (i * 64 + lane) * 4); v[i] = make_float4(bflo(t.x), bfhi(t.x), bflo(t.y), bfhi(t.y)); }
#pragma unroll 1
      for (int s2 = 1; s2 < 8; ++s2) {
#pragma unroll
        for (int i = 0; i < 8; ++i) { const u32x2 t = *(const u32x2*)(fpb + (size_t)s2 * 512 * D + (i * 64 + lane) * 4); v[i].x += bflo(t.x); v[i].y += bfhi(t.x); v[i].z += bflo(t.y); v[i].w += bfhi(t.y); } }
#pragma unroll
      for (int i = 0; i < 8; ++i) { u32x2 pw; pw.x = pk2(v[i].x, v[i].y); pw.y = pk2(v[i].z, v[i].w); *(u32x2*)(XN + (size_t)(MPR + r) * D + (i * 64 + lane) * 4) = pw; } }
    xcd_barrier(xb); FRESH_TID();
    { pg8::EpiBf16P E{FB, D}; run_gemm(lds, XN, (const bf16_t*)(ws + OFF_WOUT), MPR, D, D, E, G, gid); }
    __syncthreads();
    run_gemm_split(lds, XN, (const bf16_t*)(ws + OFF_WOUT), D, 256, FP, G - 1 - gid);
    xcd_barrier(xb); FRESH_TID();
    for (int r = bid * 8 + wv; r < MT; r += G * 8) rowop<true, true, true, true, true>(nullptr, r < MPR ? nullptr : (const float*)((const bf16_t*)FP + (size_t)(r - MPR) * D), r < MPR ? FB + (size_t)r * D : nullptr, r < MPR ? 1 : 8, 1.0f, p.in[23], p.in[24], nullptr, XN + (size_t)r * D, lane, XB1 + (size_t)r * D, XB2 + (size_t)r * D);
    DRAIN_TR();
    xcd_barrier(xb); FRESH_TID();
    { pg8::EpiSwiglu E{R1, DFF}; run_gemm(lds, XN, (const bf16_t*)(ws + OFF_WGU), MT, 2 * DFF, D, E, G, gid); }
    xcd_barrier(xb); FRESH_TID();
    { pg8::EpiBf16P E{FB, D}; run_gemm(lds, R1, (const bf16_t*)(ws + OFF_WD), MPR, D, DFF, E, G, gid); }
    __syncthreads();
    run_gemm_split(lds, R1, (const bf16_t*)(ws + OFF_WD), DFF, 512, FP, G - 1 - gid);
    xcd_barrier(xb); FRESH_TID();
    for (int r = bid * 8 + wv; r < MT; r += G * 8) rowop<true, true, false, true, false>(nullptr, r < MPR ? nullptr : (const float*)((const bf16_t*)FP + (size_t)(r - MPR) * D), r < MPR ? FB + (size_t)r * D : nullptr, r < MPR ? 1 : 11, 0.5f, p.in[28], nullptr, Y + (size_t)r * D, nullptr, lane, XB2 + (size_t)r * D);
}

extern "C" void kernel_launch(void* const* d_in, const int* in_sizes, int n_in, void* d_out, int out_size, void* d_ws, size_t ws_size, hipStream_t stream) {
    static int grid_blocks = 0;
    if (grid_blocks == 0) {
        int dev = 0, cus = 0, per_cu = 0;
        hipGetDevice(&dev);
        hipDeviceGetAttribute(&cus, hipDeviceAttributeMultiprocessorCount, dev);
        if (hipFuncSetAttribute((const void*)fwd_megakernel, hipFuncAttributeMaxDynamicSharedMemorySize, LDS_BYTES) != hipSuccess) fprintf(stderr, "kernel_launch: hipFuncSetAttribute failed\n");
        if (hipOccupancyMaxActiveBlocksPerMultiprocessor(&per_cu, (const void*)fwd_megakernel, 512, LDS_BYTES) != hipSuccess || per_cu < 1) { fprintf(stderr, "kernel_launch: occupancy query gave %d\n", per_cu); per_cu = 1; }
        (void)hipGetLastError();
        grid_blocks = cus * (per_cu > 1 ? 1 : per_cu);
        if (ws_size < WS_END + 16384) fprintf(stderr, "kernel_launch: workspace too small: %zu < %zu\n", ws_size, (size_t)WS_END);
        if (n_in != 29) fprintf(stderr, "kernel_launch: expected 29 inputs, got %d\n", n_in);
    }
    if (hipMemsetAsync((unsigned char*)d_ws + OFF_BAR, 0, 16384, stream) != hipSuccess) fprintf(stderr, "kernel_launch: memset failed\n");
    if (hipMemsetAsync((unsigned char*)d_ws + OFF_CTL, 0, 4096, stream) != hipSuccess) fprintf(stderr, "kernel_launch: memset failed\n");
    Params p{};
    for (int i = 0; i < 29; ++i) p.in[i] = (const float*)d_in[i];
    p.out = (float*)d_out; p.ws = (unsigned char*)d_ws;
    void* args[] = {&p};
    hipError_t e = hipLaunchCooperativeKernel((const void*)fwd_megakernel, dim3(grid_blocks), dim3(512), args, LDS_BYTES, stream);
    if (e != hipSuccess) fprintf(stderr, "kernel_launch: cooperative launch failed: %s (grid %d)\n", hipGetErrorString(e), grid_blocks);
}
```

```cpp
#include <hip/hip_runtime.h>
#include <hip/hip_cooperative_groups.h>
#include <cstdio>
namespace cg = cooperative_groups;
namespace pg8 {
#define PG8_LAS __attribute__((address_space(3)))
typedef unsigned short bf16_t;
typedef short bf16x8 __attribute__((ext_vector_type(8)));
typedef float f32x4 __attribute__((ext_vector_type(4)));
typedef unsigned u32x4 __attribute__((ext_vector_type(4)));
constexpr int BM = 256, BK = 64, HALF = 128, HTB = HALF * BK * 2  , STAGE_BYTES = 8 * HTB, NXCD = 8, WGM = 8;

__host__ __device__ __forceinline__ int lds_byte(int r, int c) { const int st = (r >> 4) * 2 + (c >> 5), rr = r & 15, cc = c & 31, ob = rr * 64 + cc * 2; return st * 1024 + (ob ^ (((ob >> 9) & 1) << 5)); }
__host__ __device__ __forceinline__ void stage_rc(int b, int& R, int& C) { const int st = b / 1024, sb = b % 1024, swz = sb ^ (((sb >> 9) & 1) << 5); R = (st >> 1) * 16 + swz / 64; C = (st & 1) * 32 + (swz % 64) / 2; }
__host__ __device__ __forceinline__ int perm32(int rho) { const int n = rho >> 4, i = rho & 15; return 8 * (i >> 2) + 4 * n + (i & 3); }

struct Unit { int pm, pn; };
struct Gemm { const bf16_t* A; const bf16_t* Bt; int M, N, K, lda, ldb; };

struct StaticOrder {
    int nM, nN, nwg, G, c;
    __host__ __device__ void init(int M, int N, int G_, int c_) { nM = M / BM; nN = N / BM; nwg = nM * nN; G = G_; c = c_; }
    __host__ __device__ bool next(int i, Unit& u) const {
        const long L = (long)i * G + c; if (L >= nwg) return false;
        int wgid = (int)L; { const int q = nwg / NXCD, r = nwg % NXCD, xcd = wgid % NXCD, off = wgid / NXCD; wgid = (xcd < r ? xcd * (q + 1) : r * (q + 1) + (xcd - r) * q) + off; }
        const int nig = WGM * nN, gid = wgid / nig, fm = gid * WGM, gsz = (nM - fm) < WGM ? (nM - fm) : WGM;
        u.pm = fm + ((wgid % nig) % gsz); u.pn = (wgid % nig) / gsz; return true;
    }
    __device__ __forceinline__ void a_ready(const Unit&) const {}
    __device__ __forceinline__ void done(const Unit&) const {}
};
__device__ __forceinline__ unsigned cvt_pk_bf16(float lo, float hi) { unsigned r; asm volatile("v_cvt_pk_bf16_f32 %0, %1, %2" : "=v"(r) : "v"(lo), "v"(hi)); return r; }
struct EpiF32 {
    static constexpr bool PERM = false, AFTER_DRAIN = false;
    float* C; int ldc; const float* bias;
    __device__ __forceinline__ void operator()(const f32x4 (&acc)[2][2][4][2], const Unit& u, int wr, int wc, int fr, int fq) const {
        const int row0 = u.pm * BM + wr * 64 + fr, col0 = u.pn * BM + wc * 32 + 4 * fq;
        f32x4 bv[2][2];
#pragma unroll
        for (int bj = 0; bj < 2; ++bj)
#pragma unroll
            for (int n = 0; n < 2; ++n) bv[bj][n] = bias ? *(const f32x4*)(bias + col0 + bj * HALF + n * 16) : (f32x4){0.f, 0.f, 0.f, 0.f};
#pragma unroll
        for (int ai = 0; ai < 2; ++ai)
#pragma unroll
            for (int m = 0; m < 4; ++m) { float* rowp = C + (size_t)(row0 + ai * HALF + m * 16) * ldc + col0;
#pragma unroll
                for (int bj = 0; bj < 2; ++bj)
#pragma unroll
                    for (int n = 0; n < 2; ++n) *(f32x4*)(rowp + bj * HALF + n * 16) = acc[ai][bj][m][n] + bv[bj][n]; }
    }
};
typedef unsigned u32x2 __attribute__((ext_vector_type(2)));
__device__ __forceinline__ float sigm(float x) { return __builtin_amdgcn_rcpf(1.0f + __expf(-x)); }
__device__ __forceinline__ float silu_f(float x) { return x * sigm(x); }
__device__ __forceinline__ float bf2f(unsigned short b) { return __uint_as_float(((unsigned)b) << 16); }
__device__ __forceinline__ float bflo(unsigned w) { return __uint_as_float(w << 16); }
__device__ __forceinline__ float bfhi(unsigned w) { return __uint_as_float(w & 0xffff0000u); }
struct EpiBf16P {
    static constexpr bool PERM = true, AFTER_DRAIN = false;
    bf16_t* O; int ldc;
    __device__ __forceinline__ void operator()(const f32x4 (&acc)[2][2][4][2], const Unit& u, int wr, int wc, int fr, int fq) const {
        const int row0 = u.pm * BM + wr * 64 + fr, col0 = u.pn * BM + wc * 32 + 8 * fq;
#pragma unroll
        for (int ai = 0; ai < 2; ++ai)
#pragma unroll
            for (int m = 0; m < 4; ++m) { bf16_t* rowp = O + (size_t)(row0 + ai * HALF + m * 16) * ldc + col0;
#pragma unroll
                for (int bj = 0; bj < 2; ++bj) { const f32x4 v0 = acc[ai][bj][m][0], v1 = acc[ai][bj][m][1];
                    u32x4 w; w.x = cvt_pk_bf16(v0[0], v0[1]); w.y = cvt_pk_bf16(v0[2], v0[3]); w.z = cvt_pk_bf16(v1[0], v1[1]); w.w = cvt_pk_bf16(v1[2], v1[3]);
                    *(u32x4*)(rowp + bj * HALF) = w; } }
    }
};
struct EpiSwiglu {
    static constexpr bool PERM = true, AFTER_DRAIN = false;
    bf16_t* O; int ldc;
    __device__ __forceinline__ void operator()(const f32x4 (&acc)[2][2][4][2], const Unit& u, int wr, int wc, int fr, int fq) const {
        const int row0 = u.pm * BM + wr * 64 + fr, col0 = u.pn * HALF + wc * 32 + 8 * fq;
#pragma unroll
        for (int ai = 0; ai < 2; ++ai)
#pragma unroll
            for (int m = 0; m < 4; ++m) { bf16_t* rowp = O + (size_t)(row0 + ai * HALF + m * 16) * ldc + col0;
                const f32x4 g0 = acc[ai][0][m][0], g1 = acc[ai][0][m][1], u0 = acc[ai][1][m][0], u1 = acc[ai][1][m][1];
                float r[8];
#pragma unroll
                for (int j = 0; j < 4; ++j) { r[j] = silu_f(g0[j]) * u0[j]; r[4 + j] = silu_f(g1[j]) * u1[j]; }
                u32x4 w; w.x = cvt_pk_bf16(r[0], r[1]); w.y = cvt_pk_bf16(r[2], r[3]); w.z = cvt_pk_bf16(r[4], r[5]); w.w = cvt_pk_bf16(r[6], r[7]);
                *(u32x4*)rowp = w; }
    }
};
struct EpiGate1 {
    static constexpr bool PERM = true, AFTER_DRAIN = false;
    bf16_t* C; int ldc; const bf16_t* G; int ldg;
    __device__ __forceinline__ void operator()(const f32x4 (&acc)[2][2][4][2], const Unit& u, int wr, int wc, int fr, int fq) const {
        const int row0 = u.pm * BM + wr * 64 + fr, col0 = u.pn * BM + wc * 32 + 8 * fq;
#pragma unroll
        for (int ai = 0; ai < 2; ++ai)
#pragma unroll
            for (int m = 0; m < 4; ++m) { const size_t row = (size_t)(row0 + ai * HALF + m * 16);
#pragma unroll
                for (int bj = 0; bj < 2; ++bj) { const int col = col0 + bj * HALF;
                    const u32x4 gw = *(const u32x4*)(G + row * ldg + col);
                    const f32x4 v0 = acc[ai][bj][m][0], v1 = acc[ai][bj][m][1];
                    u32x4 w; w.x = cvt_pk_bf16(sigm(bflo(gw.x)) * v0[0], sigm(bfhi(gw.x)) * v0[1]); w.y = cvt_pk_bf16(sigm(bflo(gw.y)) * v0[2], sigm(bfhi(gw.y)) * v0[3]);
                    w.z = cvt_pk_bf16(sigm(bflo(gw.z)) * v1[0], sigm(bfhi(gw.z)) * v1[1]); w.w = cvt_pk_bf16(sigm(bflo(gw.w)) * v1[2], sigm(bfhi(gw.w)) * v1[3]);
                    *(u32x4*)(C + row * ldc + col) = w; } }
    }
};
struct EpiGate2 {
    static constexpr bool PERM = true, AFTER_DRAIN = false;
    bf16_t* O; int ldc; const bf16_t* T1; const bf16_t* G; int ldg;
    __device__ __forceinline__ void operator()(const f32x4 (&acc)[2][2][4][2], const Unit& u, int wr, int wc, int fr, int fq) const {
        const int row0 = u.pm * BM + wr * 64 + fr, col0 = u.pn * BM + wc * 32 + 8 * fq;
#pragma unroll
        for (int ai = 0; ai < 2; ++ai)
#pragma unroll
            for (int m = 0; m < 4; ++m) { const size_t row = (size_t)(row0 + ai * HALF + m * 16);
#pragma unroll
                for (int bj = 0; bj < 2; ++bj) { const int col = col0 + bj * HALF;
                    const u32x4 gw = *(const u32x4*)(G + row * ldg + col);
                    const u32x4 tw = *(const u32x4*)(T1 + row * ldc + col);
                    const f32x4 t0 = {bflo(tw.x), bfhi(tw.x), bflo(tw.y), bfhi(tw.y)}, t1 = {bflo(tw.z), bfhi(tw.z), bflo(tw.w), bfhi(tw.w)};
                    const f32x4 v0 = acc[ai][bj][m][0], v1 = acc[ai][bj][m][1];
                    float r[8];
                    r[0] = t0[0] + sigm(bflo(gw.x)) * v0[0]; r[1] = t0[1] + sigm(bfhi(gw.x)) * v0[1]; r[2] = t0[2] + sigm(bflo(gw.y)) * v0[2]; r[3] = t0[3] + sigm(bfhi(gw.y)) * v0[3];
                    r[4] = t1[0] + sigm(bflo(gw.z)) * v1[0]; r[5] = t1[1] + sigm(bfhi(gw.z)) * v1[1]; r[6] = t1[2] + sigm(bflo(gw.w)) * v1[2]; r[7] = t1[3] + sigm(bfhi(gw.w)) * v1[3];
                    u32x4 w; w.x = cvt_pk_bf16(r[0], r[1]); w.y = cvt_pk_bf16(r[2], r[3]); w.z = cvt_pk_bf16(r[4], r[5]); w.w = cvt_pk_bf16(r[6], r[7]);
                    *(u32x4*)(O + row * ldc + col) = w; } }
    }
};
template <class Epi, class Sched, bool ALIGN_EPI = false, bool SP2 = false>
__device__ __forceinline__ void gemm_phase(PG8_LAS unsigned char* lds, const Gemm g, const Sched& S, const Epi& E) {
    int tid_ = threadIdx.x; asm volatile("" : "+v"(tid_));
    const int tid = tid_, wid = __builtin_amdgcn_readfirstlane(tid >> 6), lane = tid & 63, wr = wid >> 2, wc = wid & 3, fr = lane & 15, fq = lane >> 4;
    const int K = g.K, nt = K / BK;
    unsigned voffA[2], voffB[2];
#pragma unroll
    for (int i = 0; i < 2; ++i) { int R, C; stage_rc(tid * 16 + i * 8192, R, C); const int Rb = Epi::PERM ? ((R & ~31) + perm32(R & 31)) : R;
        voffA[i] = (unsigned)(R * g.lda + C) * 2u; voffB[i] = (unsigned)(Rb * g.ldb + C) * 2u; }
    const size_t kstep = (size_t)(BK * 2);
    const size_t hstepA = (size_t)HALF * g.lda * 2, hstepB = (size_t)HALF * g.ldb * 2;
    const size_t tstepA = 2 * hstepA, tstepB = 2 * hstepB;
    const unsigned ldsw = (unsigned)wid * 1024u;
    const int aoff = lds_byte(wr * 64 + fr, fq * 8), boff = lds_byte(wc * 32 + fr, fq * 8);
#define PG8_SA(b, h) (((b) * 2 + (h)) * HTB)
#define PG8_SB(b, h) ((4 + (b) * 2 + (h)) * HTB)
#define PG8_STAGE(bufoff, gbase, voff) do { _Pragma("unroll") for (int _i = 0; _i < 2; ++_i) \
        __builtin_amdgcn_global_load_lds((const unsigned*)((const char*)(gbase) + (voff)[_i]), (PG8_LAS unsigned*)(lds + (bufoff) + ldsw + _i * 8192), 16, 0, 0); } while (0)
#define PG8_LDA(dst, b, h) do { _Pragma("unroll") for (int m = 0; m < 4; ++m) _Pragma("unroll") for (int k = 0; k < 2; ++k) dst[m][k] = *(const PG8_LAS bf16x8*)(lds + PG8_SA(b, h) + aoff + m * 2048 + k * 1024); } while (0)
#define PG8_LDB(dst, b, h) do { _Pragma("unroll") for (int n = 0; n < 2; ++n) _Pragma("unroll") for (int k = 0; k < 2; ++k) dst[n][k] = *(const PG8_LAS bf16x8*)(lds + PG8_SB(b, h) + boff + n * 2048 + k * 1024); } while (0)
#define PG8_MMA(ai, bj, At, Bt) do { __builtin_amdgcn_s_setprio(1); _Pragma("unroll") for (int m = 0; m < 4; ++m) _Pragma("unroll") for (int n = 0; n < 2; ++n) _Pragma("unroll") for (int k = 0; k < 2; ++k) \
        acc[ai][bj][m][n] = __builtin_amdgcn_mfma_f32_16x16x32_bf16(Bt[n][k], At[m][k], acc[ai][bj][m][n], 0, 0, 0); __builtin_amdgcn_s_setprio(0); } while (0)
#define PG8_WAIT_V(n) asm volatile("s_waitcnt vmcnt(" #n ")" ::: "memory")
#define PG8_WAIT_L(n) asm volatile("s_waitcnt lgkmcnt(" #n ")" ::: "memory")
#define PG8_BAR __builtin_amdgcn_s_barrier()
#define PG8_SCHED __builtin_amdgcn_sched_barrier(0)
    Unit cur, nxt; int ui = 0;
    if (!S.next(0, cur)) return;
    f32x4 acc[2][2][4][2];
#pragma unroll
    for (int a = 0; a < 2; ++a)
#pragma unroll
        for (int b = 0; b < 2; ++b)
#pragma unroll
            for (int m = 0; m < 4; ++m)
#pragma unroll
                for (int n = 0; n < 2; ++n) acc[a][b][m][n] = (f32x4){0.f, 0.f, 0.f, 0.f};
    bf16x8 At[4][2], B0[2][2], B1[2][2];
    const char* cA = (const char*)g.A + (size_t)cur.pm * tstepA; const char* cB = (const char*)g.Bt + (size_t)cur.pn * tstepB;
    S.a_ready(cur);
    if constexpr (SP2) {
        PG8_STAGE(PG8_SB(0, 0), cB, voffB); PG8_STAGE(PG8_SB(0, 1), cB + hstepB, voffB); PG8_STAGE(PG8_SA(0, 0), cA, voffA); PG8_STAGE(PG8_SA(0, 1), cA + hstepA, voffA);
        if (wr == 1) PG8_BAR;
        PG8_WAIT_V(2); PG8_BAR;
        PG8_STAGE(PG8_SB(1, 0), cB + kstep, voffB); PG8_STAGE(PG8_SA(1, 0), cA + kstep, voffA); PG8_STAGE(PG8_SB(1, 1), cB + hstepB + kstep, voffB);
        PG8_WAIT_V(6); PG8_BAR;
    } else {
        PG8_STAGE(PG8_SB(0, 0), cB, voffB); PG8_STAGE(PG8_SA(0, 0), cA, voffA); PG8_STAGE(PG8_SB(0, 1), cB + hstepB, voffB); PG8_STAGE(PG8_SA(0, 1), cA + hstepA, voffA);
        if (wr == 1) PG8_BAR;
        PG8_WAIT_V(4); PG8_BAR;
        PG8_STAGE(PG8_SB(1, 0), cB + kstep, voffB); PG8_STAGE(PG8_SA(1, 0), cA + kstep, voffA); PG8_STAGE(PG8_SB(1, 1), cB + hstepB + kstep, voffB);
        PG8_WAIT_V(6); PG8_BAR;
    }
    for (;;) {
        const bool has_next = S.next(ui + 1, nxt);
        const char* nA = has_next ? (const char*)g.A + (size_t)nxt.pm * tstepA : cA; const char* nB = has_next ? (const char*)g.Bt + (size_t)nxt.pn * tstepB : cB;
        for (int t = 0; t < nt; t += 2) {
            const bool last = (t == nt - 2);
            const char* a1 = cA + (size_t)(t + 1) * kstep;
            const char* a2 = last ? nA : cA + (size_t)(t + 2) * kstep; const char* b2 = last ? nB : cB + (size_t)(t + 2) * kstep;
            const char* a3 = a2 + kstep; const char* b3 = b2 + kstep;
            if (last && has_next) S.a_ready(nxt);
            if constexpr (SP2) {
            PG8_LDB(B0, 0, 0); PG8_LDB(B1, 0, 1); PG8_SCHED; PG8_LDA(At, 0, 0); PG8_STAGE(PG8_SA(1, 1), a1 + hstepA, voffA);
            PG8_WAIT_V(8); PG8_WAIT_L(0); PG8_BAR; PG8_MMA(0, 0, At, B0); PG8_MMA(0, 1, At, B1); PG8_BAR; PG8_SCHED;
            PG8_LDA(At, 0, 1); PG8_STAGE(PG8_SB(0, 0), b2, voffB); PG8_STAGE(PG8_SB(0, 1), b2 + hstepB, voffB); PG8_STAGE(PG8_SA(0, 0), a2, voffA);
            PG8_WAIT_V(8); PG8_WAIT_L(0); PG8_BAR; PG8_MMA(1, 0, At, B0); PG8_MMA(1, 1, At, B1); PG8_BAR; PG8_SCHED;
            PG8_LDB(B0, 1, 0); PG8_LDB(B1, 1, 1); PG8_SCHED; PG8_LDA(At, 1, 0); PG8_STAGE(PG8_SA(0, 1), a2 + hstepA, voffA);
            PG8_WAIT_V(8); PG8_WAIT_L(0); PG8_BAR; PG8_MMA(0, 0, At, B0); PG8_MMA(0, 1, At, B1); PG8_BAR; PG8_SCHED;
            PG8_LDA(At, 1, 1); PG8_STAGE(PG8_SB(1, 0), b3, voffB); PG8_STAGE(PG8_SB(1, 1), b3 + hstepB, voffB); PG8_STAGE(PG8_SA(1, 0), a3, voffA);
            PG8_WAIT_V(8); PG8_WAIT_L(0); PG8_BAR; PG8_MMA(1, 0, At, B0); PG8_MMA(1, 1, At, B1); PG8_BAR; PG8_SCHED;
            } else {
            PG8_LDB(B0, 0, 0); PG8_SCHED; PG8_LDA(At, 0, 0); PG8_STAGE(PG8_SA(1, 1), a1 + hstepA, voffA);
            PG8_WAIT_L(8); PG8_BAR; PG8_WAIT_L(0); PG8_MMA(0, 0, At, B0); PG8_BAR; PG8_SCHED;
            PG8_LDB(B1, 0, 1); PG8_STAGE(PG8_SB(0, 0), b2, voffB);
            PG8_BAR; PG8_WAIT_L(0); PG8_MMA(0, 1, At, B1); PG8_BAR;
            PG8_LDA(At, 0, 1); PG8_STAGE(PG8_SA(0, 0), a2, voffA);
            PG8_BAR; PG8_WAIT_L(0); PG8_MMA(1, 0, At, B0); PG8_BAR; PG8_SCHED;
            PG8_STAGE(PG8_SB(0, 1), b2 + hstepB, voffB);
            PG8_WAIT_V(6); PG8_BAR; PG8_MMA(1, 1, At, B1); PG8_BAR;
            PG8_LDB(B0, 1, 0); PG8_SCHED; PG8_LDA(At, 1, 0); PG8_STAGE(PG8_SA(0, 1), a2 + hstepA, voffA);
            PG8_WAIT_L(8); PG8_BAR; PG8_WAIT_L(0); PG8_MMA(0, 0, At, B0); PG8_BAR; PG8_SCHED;
            PG8_LDB(B1, 1, 1); PG8_STAGE(PG8_SB(1, 0), b3, voffB);
            PG8_BAR; PG8_WAIT_L(0); PG8_MMA(0, 1, At, B1); PG8_BAR;
            PG8_LDA(At, 1, 1); PG8_STAGE(PG8_SA(1, 0), a3, voffA);
            PG8_BAR; PG8_WAIT_L(0); PG8_MMA(1, 0, At, B0); PG8_BAR; PG8_SCHED;
            PG8_STAGE(PG8_SB(1, 1), b3 + hstepB, voffB);
            PG8_WAIT_V(6); PG8_BAR; PG8_MMA(1, 1, At, B1); PG8_BAR;
            }
        }
        if constexpr (ALIGN_EPI) { if (wr == 0) PG8_BAR; }
        if constexpr (!Epi::AFTER_DRAIN) { E(acc, cur, wr, wc, fr, fq); S.done(cur); }
        if (!has_next) break;
#pragma unroll
        for (int a = 0; a < 2; ++a)
#pragma unroll
            for (int b = 0; b < 2; ++b)
#pragma unroll
                for (int m = 0; m < 4; ++m)
#pragma unroll
                    for (int n = 0; n < 2; ++n) acc[a][b][m][n] = (f32x4){0.f, 0.f, 0.f, 0.f};
        cur = nxt; cA = nA; cB = nB; ++ui;
        if constexpr (ALIGN_EPI) { if (wr == 1) PG8_BAR; }
    }
    PG8_WAIT_V(0);
    if constexpr (!ALIGN_EPI) { if (wr == 0) PG8_BAR; }
    PG8_BAR;
    if constexpr (Epi::AFTER_DRAIN) { E.fused(acc, cur, wr, wc, fr, fq, lds, wid, lane); S.done(cur); }
#undef PG8_SA
#undef PG8_SB
#undef PG8_STAGE
#undef PG8_LDA
#undef PG8_LDB
#undef PG8_MMA
#undef PG8_WAIT_V
#undef PG8_WAIT_L
#undef PG8_BAR
#undef PG8_SCHED
}
}

using pg8::bf16_t; using pg8::bf16x8; using pg8::f32x4; using pg8::u32x4; using pg8::u32x2;
using pg8::sigm; using pg8::silu_f; using pg8::bf2f; using pg8::bflo; using pg8::bfhi;
#define LAS __attribute__((address_space(3)))
#define DI __device__ __forceinline__
typedef short s16x4 __attribute__((ext_vector_type(4)));
typedef float f32x2 __attribute__((ext_vector_type(2)));
typedef __bf16 bf2v __attribute__((ext_vector_type(2)));

constexpr int D = 2048, DFF = 5632, MT = 8704, MPR = 8192, DINP = 10496;
constexpr int C_Z = 3072, C_B = 4096, C_A = 4104, C_QM = 4112, C_CKV = 5648, C_KR = 6160, C_GG = 6224, C_GM = 8272;
constexpr size_t O_CONVP = 17825792, O_SSMP = 17844224, O_CKVP = 18106368, O_KRP = 22300672, O_CONVS = 22824960, O_SSMS = 22972416, O_CKVS = 25069568, O_KRS = 25331712;
constexpr size_t OFF_WIN = 0, OFF_WBRG = 42991616, OFF_WBRM = 47185920, OFF_WOUT = 51380224, OFF_WUK = 59768832, OFF_WUV = 60817408,
                 OFF_WGU = 61865984, OFF_WD = 108003328, OFF_XN = 131072000, OFF_QP = OFF_XN, OFF_CKVB = OFF_XN + 25165824, OFF_KRB = OFF_XN + 34078720,
                 OFF_R1 = 166723584, OFF_F = 349437952, OFF_GO = OFF_F, OFF_PO = OFF_F + 35651584, OFF_KV = 420741120, OFF_OM = 454295552, OFF_OG = 472121344,
                 OFF_QS = 489947136, OFF_ML = 494665728, OFF_CTL = 494796800, OFF_GP = 494800896, GP_STRIDE = 90368, WS_END = OFF_GP + 1152 * GP_STRIDE, OFF_BAR = WS_END, OFF_KCR = WS_END + 16384, OFF_KCC = OFF_WGU, WS_TOTAL = OFF_KCR + 8388608;
constexpr int LDS_BYTES = 155648, LDS_CTL = 155392;
constexpr float QSCALE = 0.10411754f;
constexpr float NEPS = 1e-6f;

struct Params { const float* in[29]; float* out; unsigned char* ws; };

DI unsigned pk2(float lo, float hi) { f32x2 v = {lo, hi}; bf2v b = __builtin_convertvector(v, bf2v); return __builtin_bit_cast(unsigned, b); }
DI unsigned short f2bf(float f) { __bf16 b = (__bf16)f; return __builtin_bit_cast(unsigned short, b); }
DI float wave_sum(float v) {
#pragma unroll
    for (int o = 32; o; o >>= 1) v += __shfl_xor(v, o);
    return v; }
DI f32x4 mfma16(bf16x8 a, bf16x8 b, f32x4 c) { return __builtin_amdgcn_mfma_f32_16x16x32_bf16(a, b, c, 0, 0, 0); }
DI s16x4 tr_read(const LAS bf16_t* p) { return __builtin_amdgcn_ds_read_tr16_b64_v4i16((LAS s16x4*)p); }
DI void unpack8(u32x4 w, float* x) { x[0] = bflo(w.x); x[1] = bfhi(w.x); x[2] = bflo(w.y); x[3] = bfhi(w.y); x[4] = bflo(w.z); x[5] = bfhi(w.z); x[6] = bflo(w.w); x[7] = bfhi(w.w); }
DI u32x4 pack8(const float* x) { u32x4 w; w.x = pk2(x[0], x[1]); w.y = pk2(x[2], x[3]); w.z = pk2(x[4], x[5]); w.w = pk2(x[6], x[7]); return w; }

struct TJ { const float* src; bf16_t* dst; int K, N, ldd, mode; };
template <class JOBFN>
DI void transpose_pass4(LAS float* tiles, const Params& p, int t0, JOBFN jobfn, int tid, bool& any) {
    TJ j[4]; int tk[4], tn[4]; bool ok[4];
#pragma unroll
    for (int u = 0; u < 4; ++u) ok[u] = jobfn(p, t0 + u, j[u], tk[u], tn[u]);
    any = ok[0];
    if (!any) return;
    const int r = tid >> 4, c4 = (tid & 15) * 4;
    float4 v0[4], v1[4];
#pragma unroll
    for (int u = 0; u < 4; ++u) { v0[u] = make_float4(0.f, 0.f, 0.f, 0.f); v1[u] = v0[u];
      if (ok[u] && tn[u] * 64 + c4 < j[u].N) { const float* s = j[u].src + (size_t)(tk[u] * 64 + r) * j[u].N + tn[u] * 64 + c4; const f32x4 t0 = __builtin_nontemporal_load((const f32x4*)s), t1 = __builtin_nontemporal_load((const f32x4*)(s + (size_t)32 * j[u].N)); v0[u] = make_float4(t0[0], t0[1], t0[2], t0[3]); v1[u] = make_float4(t1[0], t1[1], t1[2], t1[3]); } }
#pragma unroll
    for (int u = 0; u < 4; ++u) { LAS float* t0p = tiles + u * 4160 + r * 65 + c4; t0p[0] = v0[u].x; t0p[1] = v0[u].y; t0p[2] = v0[u].z; t0p[3] = v0[u].w;
      LAS float* t1p = t0p + 32 * 65; t1p[0] = v1[u].x; t1p[1] = v1[u].y; t1p[2] = v1[u].z; t1p[3] = v1[u].w; }
    __syncthreads();
    const int n = tid >> 3, k8 = (tid & 7) * 8;
#pragma unroll
    for (int u = 0; u < 4; ++u) { const int gn = tn[u] * 64 + n;
      if (ok[u] && gn < j[u].N) { float e[8];
#pragma unroll
        for (int q = 0; q < 8; ++q) e[q] = tiles[u * 4160 + (k8 + q) * 65 + n];
        const int drow = j[u].mode == 0 ? gn : ((gn >> 7) * 256 + (gn & 127) + (j[u].mode == 2 ? 128 : 0));
        *(u32x4*)(j[u].dst + (size_t)drow * j[u].ldd + tk[u] * 64 + k8) = pack8(e); } }
    __syncthreads();
}
#define TJOB(SRC, DST, K_, N_, MODE) { const int ntn = ((N_) + 63) / 64, nt = ((K_) / 64) * ntn; if (t < nt) { j.src = (SRC); j.dst = (bf16_t*)(DST); j.K = (K_); j.N = (N_); j.ldd = (K_); j.mode = (MODE); tk = t / ntn; tn = t % ntn; return true; } t -= nt; }
DI bool tjob_p0(const Params& p, int t, TJ& j, int& tk, int& tn) {
    unsigned char* ws = p.ws;
    TJOB(p.in[7], ws + OFF_WGU, 2048, 5632, 1)
    TJOB(p.in[8], ws + OFF_WGU, 2048, 5632, 2)
    TJOB(p.in[9], ws + OFF_WD, 5632, 2048, 0)
    return false;
}
DI bool tjob_win(const Params& p, int t, TJ& j, int& tk, int& tn) {
    unsigned char* ws = p.ws;
    TJOB(p.in[12], ws + OFF_WIN, 2048, 10320, 0)
    return false;
}
DI bool tjob_late(const Params& p, int t, TJ& j, int& tk, int& tn) {
    unsigned char* ws = p.ws;
    TJOB(p.in[18], ws + OFF_WUK, 512, 1024, 0)
    TJOB(p.in[19], ws + OFF_WUV, 512, 1024, 0)
    TJOB(p.in[20], ws + OFF_WBRG, 1024, 2048, 0)
    TJOB(p.in[21], ws + OFF_WBRM, 1024, 2048, 0)
    TJOB(p.in[22], ws + OFF_WOUT, 2048, 2048, 0)
    return false;
}
DI bool tjob_p3(const Params& p, int t, TJ& j, int& tk, int& tn) {
    unsigned char* ws = p.ws;
    TJOB(p.in[25], ws + OFF_WGU, 2048, 5632, 1)
    TJOB(p.in[26], ws + OFF_WGU, 2048, 5632, 2)
    TJOB(p.in[27], ws + OFF_WD, 5632, 2048, 0)
    return false;
}

template <bool HAS_F, bool W_Y, bool W_XN, bool RB = false, bool YB = false>
DI void rowop(const float* resid, const float* f, const bf16_t* fb, int nsum, float alpha, const float* gpost, const float* gnext, float* y, bf16_t* xn, int lane, const bf16_t* residb = nullptr, bf16_t* yb = nullptr) {
    float4 v[8];
#pragma unroll
    for (int i = 0; i < 8; ++i) { if (RB) { const u32x2 t = *(const u32x2*)(residb + (i * 64 + lane) * 4); v[i] = make_float4(bflo(t.x), bfhi(t.x), bflo(t.y), bfhi(t.y)); } else { const f32x4 t = __builtin_nontemporal_load((const f32x4*)(resid + (i * 64 + lane) * 4)); v[i] = make_float4(t[0], t[1], t[2], t[3]); } }
    if (HAS_F) {
        float4 fv[8]; float ss = 0.f;
        { const bf16_t* f0 = fb ? fb : (const bf16_t*)f;
#pragma unroll
          for (int i = 0; i < 8; ++i) { const u32x2 t = *(const u32x2*)(f0 + (i * 64 + lane) * 4); fv[i] = make_float4(bflo(t.x), bfhi(t.x), bflo(t.y), bfhi(t.y)); } }
#pragma unroll 1
        for (int s = 1; s < nsum; ++s) {
#pragma unroll
          for (int i = 0; i < 8; ++i) { const u32x2 t = *(const u32x2*)((const bf16_t*)f + (size_t)s * 512 * 2048 + (i * 64 + lane) * 4); fv[i].x += bflo(t.x); fv[i].y += bfhi(t.x); fv[i].z += bflo(t.y); fv[i].w += bfhi(t.y); } }
#pragma unroll
        for (int i = 0; i < 8; ++i) ss += fv[i].x * fv[i].x + fv[i].y * fv[i].y + fv[i].z * fv[i].z + fv[i].w * fv[i].w;
        ss = wave_sum(ss); const float rs = rsqrtf(ss * (1.0f / 2048.0f) + NEPS) * alpha;
#pragma unroll
        for (int i = 0; i < 8; ++i) { const float4 g = *(const float4*)(gpost + (i * 64 + lane) * 4);
            v[i].x += fv[i].x * rs * g.x; v[i].y += fv[i].y * rs * g.y; v[i].z += fv[i].z * rs * g.z; v[i].w += fv[i].w * rs * g.w; }
    }
    if (W_Y) {
#pragma unroll
        for (int i = 0; i < 8; ++i) { if (YB) { u32x2 w; w.x = pk2(v[i].x, v[i].y); w.y = pk2(v[i].z, v[i].w); *(u32x2*)(yb + (i * 64 + lane) * 4) = w; } else *(float4*)(y + (i * 64 + lane) * 4) = v[i]; }
    }
    if (W_XN) {
        float ss = 0.f;
#pragma unroll
        for (int i = 0; i < 8; ++i) ss += v[i].x * v[i].x + v[i].y * v[i].y + v[i].z * v[i].z + v[i].w * v[i].w;
        ss = wave_sum(ss); const float rs = rsqrtf(ss * (1.0f / 2048.0f) + NEPS);
#pragma unroll
        for (int i = 0; i < 8; ++i) { const float4 g = *(const float4*)(gnext + (i * 64 + lane) * 4);
            u32x2 w; w.x = pk2(v[i].x * rs * g.x, v[i].y * rs * g.y); w.y = pk2(v[i].z * rs * g.z, v[i].w * rs * g.w);
            *(u32x2*)(xn + (i * 64 + lane) * 4) = w; }
    }
}
DI const float* xin_row(const Params& p, int r) { return r < MPR ? p.in[0] + (size_t)r * D : p.in[1] + (size_t)(r - MPR) * D; }

DI void mla_prep_row(const Params& p, int r, int lane) {
    unsigned char* ws = p.ws;
    const bf16_t* pr = (const bf16_t*)(ws + OFF_R1) + (size_t)r * DINP;
    const bool samp = r >= MPR; const int rs = r - MPR; const int pos = samp ? 4096 + (rs & 31) : (r & 4095);
    { float x[8]; unpack8(*(const u32x4*)(pr + C_CKV + lane * 8), x);
      float ss = 0.f;
#pragma unroll
      for (int i = 0; i < 8; ++i) ss += x[i] * x[i];
      ss = wave_sum(ss); const float rn = rsqrtf(ss * (1.0f / 512.0f) + NEPS);
      const float4 g0 = *(const float4*)(p.in[17] + lane * 8), g1 = *(const float4*)(p.in[17] + lane * 8 + 4);
      x[0] *= rn * g0.x; x[1] *= rn * g0.y; x[2] *= rn * g0.z; x[3] *= rn * g0.w; x[4] *= rn * g1.x; x[5] *= rn * g1.y; x[6] *= rn * g1.z; x[7] *= rn * g1.w;
      float* o = p.out + (samp ? O_CKVS + (size_t)rs * 512 : O_CKVP + (size_t)r * 512) + lane * 8;
      *(float4*)o = make_float4(x[0], x[1], x[2], x[3]); *(float4*)(o + 4) = make_float4(x[4], x[5], x[6], x[7]);
      *(u32x4*)((bf16_t*)(ws + OFF_CKVB) + (size_t)r * 512 + lane * 8) = pack8(x); }
    const int i = lane & 31;
    const float inv = exp2f(-(float)i * 0.41524101186f); float rev = (float)pos * inv * 0.15915494309f; rev -= floorf(rev);
    const float sn = __builtin_amdgcn_sinf(rev), cs = __builtin_amdgcn_cosf(rev);
    if (lane < 32) { const float x1 = bf2f(pr[C_KR + i]), x2 = bf2f(pr[C_KR + 32 + i]);
      const float o1 = x1 * cs - x2 * sn, o2 = x2 * cs + x1 * sn;
      float* o = p.out + (samp ? O_KRS + (size_t)rs * 64 : O_KRP + (size_t)r * 64);
      o[i] = o1; o[32 + i] = o2;
      bf16_t* kb = (bf16_t*)(ws + OFF_KRB) + (size_t)r * 64; kb[i] = f2bf(o1); kb[32 + i] = f2bf(o2); }
#pragma unroll
    for (int hh = 0; hh < 4; ++hh) { const int h = hh * 2 + (lane >> 5);
      const float x1 = bf2f(pr[C_QM + h * 192 + 128 + i]), x2 = bf2f(pr[C_QM + h * 192 + 160 + i]);
      const float o1 = (x1 * cs - x2 * sn) * QSCALE, o2 = (x2 * cs + x1 * sn) * QSCALE;
      bf16_t* q = samp ? (bf16_t*)(ws + OFF_QS) + ((size_t)(((rs >> 5) * 8 + h) * 32 + (rs & 31))) * 576 + 512
                       : (bf16_t*)(ws + OFF_QP) + ((size_t)r * 8 + h) * 192 + 128;
      q[i] = f2bf(o1); q[32 + i] = f2bf(o2); }
    if (!samp) {
#pragma unroll
      for (int it = 0; it < 2; ++it) { const int idx = it * 512 + lane * 8, h = idx >> 7, d = idx & 127;
        float x[8]; unpack8(*(const u32x4*)(pr + C_QM + h * 192 + d), x);
#pragma unroll
        for (int q = 0; q < 8; ++q) x[q] *= QSCALE;
        *(u32x4*)((bf16_t*)(ws + OFF_QP) + ((size_t)r * 8 + h) * 192 + d) = pack8(x); } }
}

DI void qlat_item(const Params& p, int b, int h, int tid) {
    unsigned char* ws = p.ws;
    const int w = tid >> 6, lane = tid & 63, g = lane >> 4, c16 = lane & 15;
    bf16x8 qa[2][4];
#pragma unroll
    for (int mt = 0; mt < 2; ++mt)
#pragma unroll
      for (int ks = 0; ks < 4; ++ks) qa[mt][ks] = *(const bf16x8*)((const bf16_t*)(ws + OFF_R1) + (size_t)(MPR + b * 32 + 16 * mt + c16) * DINP + C_QM + h * 192 + 32 * ks + 8 * g);
    bf16_t* qo = (bf16_t*)(ws + OFF_QS) + (size_t)((b * 8 + h) * 32) * 576;
#pragma unroll
    for (int n4 = 0; n4 < 4; ++n4) { const int c = 16 * (4 * w + n4) + c16;
      const float* wp = p.in[18] + (size_t)c * 1024 + h * 128 + 8 * g;
      float4 wl[4][2];
#pragma unroll
      for (int ks = 0; ks < 4; ++ks) { wl[ks][0] = *(const float4*)(wp + 32 * ks); wl[ks][1] = *(const float4*)(wp + 32 * ks + 4); }
      f32x4 acc[2] = {(f32x4){0.f, 0.f, 0.f, 0.f}, (f32x4){0.f, 0.f, 0.f, 0.f}};
#pragma unroll
      for (int ks = 0; ks < 4; ++ks) { u32x4 pw; pw.x = pk2(wl[ks][0].x, wl[ks][0].y); pw.y = pk2(wl[ks][0].z, wl[ks][0].w); pw.z = pk2(wl[ks][1].x, wl[ks][1].y); pw.w = pk2(wl[ks][1].z, wl[ks][1].w);
        const bf16x8 wb = __builtin_bit_cast(bf16x8, pw);
#pragma unroll
        for (int mt = 0; mt < 2; ++mt) acc[mt] = mfma16(qa[mt][ks], wb, acc[mt]); }
#pragma unroll
      for (int mt = 0; mt < 2; ++mt)
#pragma unroll
        for (int j = 0; j < 4; ++j) qo[(size_t)(16 * mt + 4 * g + j) * 576 + c] = f2bf(acc[mt][j] * QSCALE); }
}
#define XB_TMO      128
#define XB_XCNT(j)  (256  + 64 * (j))
#define XB_XSUB(j)  (1280 + 64 * (j))
#define XB_XGEN(j)  (2304 + 64 * (j))
#define XB_TOP      3328
#define XB_TOPGEN   3392
#define XCD_BAR_WORDS 3456
#define XB_SPIN_CAP (1u << 18)

__device__ __forceinline__ unsigned xb_ld(unsigned* p)              { return __hip_atomic_load(p, __ATOMIC_RELAXED, __HIP_MEMORY_SCOPE_AGENT); }
__device__ __forceinline__ unsigned xb_add(unsigned* p, unsigned v) { return __hip_atomic_fetch_add(p, v, __ATOMIC_RELAXED, __HIP_MEMORY_SCOPE_AGENT); }
__device__ __forceinline__ unsigned xb_xcc_id() { return (unsigned)__builtin_amdgcn_s_getreg((3 << 11) | 20) & 0xFu; }
#define XB_SPIN(cond, bar) do { unsigned _sp = 0; while (cond) { __builtin_amdgcn_s_sleep(1); \
    if ((++_sp & 255u) == 0u) { if (xb_ld(&(bar)[XB_TMO])) break; if (_sp > XB_SPIN_CAP) { atomicAdd(&(bar)[XB_TMO], 1u); break; } } } } while (0)

struct XcdBarrier {
    unsigned* bar; unsigned x;
    volatile LAS unsigned* st;
};

__device__ __forceinline__ XcdBarrier xcd_barrier_post(unsigned* bar, volatile LAS unsigned* st) {
    XcdBarrier b; b.bar = bar; b.x = xb_xcc_id(); b.st = st;
    if (threadIdx.x == 0) (void)xb_add(&bar[XB_XCNT(b.x)], 1u);
    return b;
}
__device__ __forceinline__ void xcd_barrier_complete(unsigned* bar, unsigned x, unsigned& nloc, unsigned& nx) {
    const unsigned G = gridDim.x * gridDim.y * gridDim.z;
    unsigned sum, cnt, mine, sp = 0u;
    for (;;) {
        sum = 0u; cnt = 0u; mine = 0u;
#pragma unroll
        for (unsigned j = 0; j < 16; ++j) { const unsigned c = xb_ld(&bar[XB_XCNT(j)]); sum += c; cnt += (c > 0u) ? 1u : 0u; mine = (j == x) ? c : mine; }
        if (sum == G) break;
        __builtin_amdgcn_s_sleep(1);
        if ((++sp & 255u) == 0u) { if (xb_ld(&bar[XB_TMO])) break; if (sp > XB_SPIN_CAP) { atomicAdd(&bar[XB_TMO], 1u); break; } }
    }
    nloc = mine > 0u ? mine : 1u; nx = cnt > 0u ? cnt : 1u;
}

__device__ __forceinline__ void xcd_barrier(const XcdBarrier& b) {
    asm volatile("s_waitcnt vmcnt(0)" ::: "memory");
    __syncthreads();
    if (threadIdx.x == 0) {
        unsigned* bar = b.bar;
        __builtin_amdgcn_s_waitcnt(0);
        unsigned nloc = b.st[0], nx = b.st[1];
        if (nloc == 0u) { xcd_barrier_complete(bar, b.x, nloc, nx); b.st[0] = nloc; b.st[1] = nx; }
        const unsigned old = xb_add(&bar[XB_XSUB(b.x)], 1u);
        const unsigned gen = old / nloc;
        if (old + 1u == (gen + 1u) * nloc) {
            __builtin_amdgcn_fence(__ATOMIC_RELEASE, "agent");
            asm volatile("s_waitcnt vmcnt(0)" ::: "memory");
            const unsigned og = xb_add(&bar[XB_TOP], 1u);
            const unsigned tg = og / nx;
            if (og + 1u == (tg + 1u) * nx) xb_add(&bar[XB_TOPGEN], 1u);
            else XB_SPIN(xb_ld(&bar[XB_TOPGEN]) == tg, bar);
            __builtin_amdgcn_fence(__ATOMIC_ACQUIRE, "agent");
            xb_add(&bar[XB_XGEN(b.x)], 1u);
            asm volatile("s_waitcnt vmcnt(0)" ::: "memory");
        } else {
            XB_SPIN(xb_ld(&bar[XB_XGEN(b.x)]) == gen, bar);
            __builtin_amdgcn_fence(__ATOMIC_ACQUIRE, "agent");
            asm volatile("s_waitcnt vmcnt(0)" ::: "memory");
        }
    }
    __syncthreads();
}

DI void gdn_prep_item(const Params& p, int item, LAS unsigned char* lds, int tid) {
    unsigned char* ws = p.ws;
    int seq, ch, h; if (item < 1024) { seq = item >> 9; ch = (item >> 3) & 63; h = item & 7; } else { const int x = item - 1024; seq = 2 + (x >> 3); ch = 0; h = x & 7; }
    const bool samp = seq >= 2; const int ntok = samp ? 32 : 64;
    const int r0 = samp ? MPR + (seq - 2) * 32 : seq * 4096 + ch * 64;
    const bf16_t* proj = (const bf16_t*)(ws + OFF_R1);
    LAS bf16_t* sqb = (LAS bf16_t*)lds; LAS bf16_t* skb = sqb + 64 * 136;
    LAS float* sk = (LAS float*)(lds + 2 * 64 * 136 * 2); LAS float* sv = sk + 64 * 132; LAS float* sA = sv + 64 * 132;
    LAS float* s_gc = sA + 64 * 68; LAS float* s_beta = s_gc + 64; LAS float* s_eg = s_beta + 64; LAS float* sW = s_eg + 64;
    unsigned char* gp = ws + OFF_GP + (size_t)item * GP_STRIDE;
    { const int i = tid >> 3, dg = tid & 7;
#pragma unroll
      for (int which = 0; which < 3; ++which) { const int col = which * 1024 + h * 128 + dg * 16;
        float y[16];
#pragma unroll
        for (int c = 0; c < 16; ++c) y[c] = 0.f;
        if (i < ntok) {
#pragma unroll
          for (int jt = 0; jt < 4; ++jt) { const int tt = i - 3 + jt; float x[16];
            if (ch * 64 + tt >= 0) { const bf16_t* s = proj + (size_t)(r0 + tt) * DINP + col; unpack8(*(const u32x4*)s, x); unpack8(*(const u32x4*)(s + 8), x + 8); }
            else if (samp) { const float* s = p.in[2] + (size_t)((seq - 2) * 3 + 3 + tt) * 3072 + col;
#pragma unroll
              for (int c4 = 0; c4 < 4; ++c4) { const float4 v = *(const float4*)(s + c4 * 4); x[c4 * 4] = v.x; x[c4 * 4 + 1] = v.y; x[c4 * 4 + 2] = v.z; x[c4 * 4 + 3] = v.w; } }
            else {
#pragma unroll
              for (int c = 0; c < 16; ++c) x[c] = 0.f; }
            const float* wp = p.in[13] + jt * 3072 + col;
#pragma unroll
            for (int c4 = 0; c4 < 4; ++c4) { const float4 wv = *(const float4*)(wp + c4 * 4);
              y[c4 * 4] += x[c4 * 4] * wv.x; y[c4 * 4 + 1] += x[c4 * 4 + 1] * wv.y; y[c4 * 4 + 2] += x[c4 * 4 + 2] * wv.z; y[c4 * 4 + 3] += x[c4 * 4 + 3] * wv.w; } }
#pragma unroll
          for (int c = 0; c < 16; ++c) y[c] = silu_f(y[c]);
        }
        if (which < 2) { float ss = 0.f;
#pragma unroll
          for (int c = 0; c < 16; ++c) ss += y[c] * y[c];
          ss += __shfl_xor(ss, 1); ss += __shfl_xor(ss, 2); ss += __shfl_xor(ss, 4);
          const float sc = rsqrtf(ss + 1e-6f) * (which == 0 ? 0.08838834764f : 1.0f);
#pragma unroll
          for (int c = 0; c < 16; ++c) y[c] *= sc; }
        if (which > 0) { LAS float* dst = (which == 1 ? sk : sv) + i * 132 + dg * 16;
#pragma unroll
          for (int c4 = 0; c4 < 4; ++c4) *(LAS f32x4*)(dst + c4 * 4) = (f32x4){y[c4 * 4], y[c4 * 4 + 1], y[c4 * 4 + 2], y[c4 * 4 + 3]}; }
        if (which < 2) { LAS bf16_t* db = (which == 0 ? sqb : skb) + i * 136 + dg * 16; *(LAS u32x4*)db = pack8(y); *(LAS u32x4*)(db + 8) = pack8(y + 8); } } }
    if (tid < 64) { float g = 0.f, beta = 0.f;
      if (tid < ntok) { const bf16_t* s = proj + (size_t)(r0 + tid) * DINP; const float braw = bf2f(s[C_B + h]), araw = bf2f(s[C_A + h]);
        beta = 1.0f / (1.0f + expf(-braw)); const float xx = araw + p.in[15][h]; const float sp = xx > 20.f ? xx : log1pf(expf(xx)); g = -expf(p.in[14][h]) * sp; }
      float gc = g;
#pragma unroll
      for (int o = 1; o < 64; o <<= 1) { const float n = __shfl_up(gc, o); if (tid >= o) gc += n; }
      s_gc[tid] = gc; s_beta[tid] = beta; s_eg[tid] = expf(gc); }
    __syncthreads();
    { const int w = tid >> 6, lane = tid & 63, g = lane >> 4, c16 = lane & 15;
      bf16_t* QKo = (bf16_t*)(gp + 81920);
#pragma unroll 1
      for (int jb = 0; jb < 4; ++jb) { const int job = w * 4 + jb, tile = job >> 1, type = job & 1, mt = tile >> 2, nt = tile & 3;
        f32x4 acc = {0.f, 0.f, 0.f, 0.f};
        if (mt >= nt) { const LAS bf16_t* ap = (type ? sqb : skb) + (16 * mt + c16) * 136 + 8 * g; const LAS bf16_t* bp = skb + (16 * nt + c16) * 136 + 8 * g;
#pragma unroll
          for (int ks = 0; ks < 4; ++ks) acc = mfma16(*(const LAS bf16x8*)(ap + 32 * ks), *(const LAS bf16x8*)(bp + 32 * ks), acc); }
        const int j = 16 * nt + c16; const float gj = s_gc[j];
#pragma unroll
        for (int jj = 0; jj < 4; ++jj) { const int i = 16 * mt + 4 * g + jj; const float dec = (i >= j) ? expf(s_gc[i] - gj) : 0.f;
          if (type == 0) sA[i * 68 + j] = (i > j) ? s_beta[i] * acc[jj] * dec : 0.f;
          else QKo[i * 64 + j] = f2bf(acc[jj] * dec); } } }
    __syncthreads();
    if (tid >= 256) { const int t2 = tid - 256; const float glast = s_gc[63];
      { const int i = t2 >> 2, d0 = (t2 & 3) * 32; const float e = s_eg[i];
#pragma unroll
        for (int c8 = 0; c8 < 4; ++c8) { float x[8];
          unpack8(*(const LAS u32x4*)(sqb + i * 136 + d0 + c8 * 8), x);
#pragma unroll
          for (int q = 0; q < 8; ++q) x[q] *= e;
          *(u32x4*)((bf16_t*)(gp + 49152) + i * 128 + d0 + c8 * 8) = pack8(x); } }
      { const int d = t2 >> 1, i0 = (t2 & 1) * 32;
#pragma unroll
        for (int c8 = 0; c8 < 4; ++c8) { float x[8];
#pragma unroll
          for (int q = 0; q < 8; ++q) { const int i = i0 + c8 * 8 + q; x[q] = sk[i * 132 + d] * expf(glast - s_gc[i]); }
          *(u32x4*)((bf16_t*)(gp + 65536) + d * 64 + i0 + c8 * 8) = pack8(x); } }
      if (t2 == 0) *(float*)(gp + 90112) = expf(glast); }
    else { const bool isW = tid >= 128; const int d = tid & 127; const LAS float* Xs = isW ? sk : sv; LAS float* X = isW ? sW : sv;
#pragma unroll 1
      for (int ib = 0; ib < (samp ? 4 : 8); ++ib) { float s[8];
#pragma unroll
        for (int r = 0; r < 8; ++r) { const int i = 8 * ib + r; s[r] = Xs[i * 132 + d] * s_beta[i] * (isW ? s_eg[i] : 1.0f); }
#pragma unroll 2
        for (int j4 = 0; j4 < 2 * ib; ++j4) { const float x0 = X[(4 * j4) * 132 + d], x1 = X[(4 * j4 + 1) * 132 + d], x2 = X[(4 * j4 + 2) * 132 + d], x3 = X[(4 * j4 + 3) * 132 + d];
#pragma unroll
          for (int r = 0; r < 8; ++r) { const f32x4 a = *(const LAS f32x4*)(sA + (8 * ib + r) * 68 + 4 * j4); s[r] -= a[0] * x0 + a[1] * x1 + a[2] * x2 + a[3] * x3; } }
#pragma unroll
        for (int r = 1; r < 8; ++r)
#pragma unroll
          for (int c = 0; c < r; ++c) s[r] -= sA[(8 * ib + r) * 68 + 8 * ib + c] * s[c];
#pragma unroll
        for (int r = 0; r < 8; ++r) X[(8 * ib + r) * 132 + d] = s[r]; }
      if (samp && isW) {
#pragma unroll 1
        for (int i = 32; i < 64; ++i) X[i * 132 + d] = 0.f; } }
    __syncthreads();
    { const int i = tid >> 3, d0 = (tid & 7) * 16;
#pragma unroll
      for (int c4 = 0; c4 < 4; ++c4) *(f32x4*)((float*)gp + i * 128 + d0 + c4 * 4) = *(const LAS f32x4*)(sv + i * 132 + d0 + c4 * 4);
#pragma unroll
      for (int c8 = 0; c8 < 2; ++c8) { float x[8];
#pragma unroll
        for (int q = 0; q < 8; ++q) x[q] = -sW[i * 132 + d0 + c8 * 8 + q];
        *(u32x4*)((bf16_t*)(gp + 32768) + i * 128 + d0 + c8 * 8) = pack8(x); } }
    __syncthreads();
}

#define LDS_BARRIER() do { asm volatile("s_waitcnt lgkmcnt(0)" ::: "memory"); __builtin_amdgcn_s_barrier(); asm volatile("" ::: "memory"); } while (0)
#ifndef REP_SCAN
#define REP_SCAN 1
#endif
struct ScanOps { bf16x8 aw[4], aq[4], aqk[2], akd[2]; f32x4 u; float eg; };
DI void scan_load(ScanOps& o, const unsigned char* gp, int w, int mt, int nt, int sl, int c16, int g) {
    const bf16_t* NW = (const bf16_t*)(gp + 32768); const bf16_t* QG = (const bf16_t*)(gp + 49152); const bf16_t* KDT = (const bf16_t*)(gp + 65536); const bf16_t* QK = (const bf16_t*)(gp + 81920);
#pragma unroll
    for (int ks = 0; ks < 4; ++ks) { o.aw[ks] = *(const bf16x8*)(NW + (16 * mt + c16) * 128 + 32 * ks + 8 * g); o.aq[ks] = *(const bf16x8*)(QG + (16 * mt + c16) * 128 + 32 * ks + 8 * g); }
#pragma unroll
    for (int ks = 0; ks < 2; ++ks) { o.aqk[ks] = *(const bf16x8*)(QK + (16 * mt + c16) * 64 + 32 * ks + 8 * g); o.akd[ks] = *(const bf16x8*)(KDT + (16 * w + c16) * 64 + 32 * ks + 8 * g); }
    const float* U = (const float*)gp + sl * 32 + 16 * nt + c16;
#pragma unroll
    for (int j = 0; j < 4; ++j) o.u[j] = U[(16 * mt + 4 * g + j) * 128];
    o.eg = *(const float*)(gp + 90112);
}
DI void scan_item(const Params& p, int sitem, LAS unsigned char* lds, int tid) {
    unsigned char* ws = p.ws;
    int seq, h, sl, nch; if (sitem < 64) { seq = sitem >> 5; h = (sitem >> 2) & 7; sl = sitem & 3; nch = 64; } else { const int x = sitem - 64; seq = 2 + (x >> 5); h = (x >> 2) & 7; sl = x & 3; nch = 1; }
    const bool samp = seq >= 2; const int ntok = samp ? 32 : 64;
    LAS bf16_t* St = (LAS bf16_t*)lds; LAS bf16_t* Vn = St + 32 * 136;
    const int w = tid >> 6, lane = tid & 63, g = lane >> 4, c16 = lane & 15, mt = w & 3, nt = w >> 2;
    f32x4 Sacc[2];
#pragma unroll
    for (int n2 = 0; n2 < 2; ++n2)
#pragma unroll
      for (int j = 0; j < 4; ++j) Sacc[n2][j] = samp ? p.in[3][((size_t)((seq - 2) * 8 + h) * 128 + 16 * w + 4 * g + j) * 128 + sl * 32 + 16 * n2 + c16] : 0.f;
#pragma unroll
    for (int n2 = 0; n2 < 2; ++n2) { u32x2 pw; pw.x = pk2(Sacc[n2][0], Sacc[n2][1]); pw.y = pk2(Sacc[n2][2], Sacc[n2][3]); *(LAS u32x2*)(St + (16 * n2 + c16) * 136 + 16 * w + 4 * g) = pw; }
    const int gitem0 = samp ? 1024 + (seq - 2) * 8 + h : (seq * 64) * 8 + h;
    const unsigned char* gp0 = ws + OFF_GP + (size_t)gitem0 * GP_STRIDE;
    ScanOps ring[3];
    scan_load(ring[0], gp0, w, mt, nt, sl, c16, g);
    scan_load(ring[1], gp0 + (size_t)(nch > 1 ? 8 : 0) * GP_STRIDE, w, mt, nt, sl, c16, g);
    __syncthreads();
    bf16_t* GO = (bf16_t*)(ws + OFF_GO);
#define SCAN_STEP(CUR, NXT2, ch_) do { const int ch = (ch_); \
      scan_load(ring[NXT2], gp0 + (size_t)(ch + 2 < nch ? ch + 2 : nch - 1) * 8 * GP_STRIDE, w, mt, nt, sl, c16, g);     \
      const int r0 = samp ? MPR + (seq - 2) * 32 : seq * 4096 + ch * 64; \
      f32x4 vacc = ring[CUR].u, oacc = {0.f, 0.f, 0.f, 0.f}; \
      _Pragma("unroll") for (int ks = 0; ks < 4; ++ks) { const bf16x8 bs = *(const LAS bf16x8*)(St + (16 * nt + c16) * 136 + 32 * ks + 8 * g); vacc = mfma16(ring[CUR].aw[ks], bs, vacc); oacc = mfma16(ring[CUR].aq[ks], bs, oacc); } \
      { u32x2 pw; pw.x = pk2(vacc[0], vacc[1]); pw.y = pk2(vacc[2], vacc[3]); *(LAS u32x2*)(Vn + (16 * nt + c16) * 72 + 16 * mt + 4 * g) = pw; } \
      LDS_BARRIER(); \
      _Pragma("unroll") for (int ks = 0; ks < 2; ++ks) { const bf16x8 bv = *(const LAS bf16x8*)(Vn + (16 * nt + c16) * 72 + 32 * ks + 8 * g); oacc = mfma16(ring[CUR].aqk[ks], bv, oacc); } \
      _Pragma("unroll") for (int j = 0; j < 4; ++j) { const int c = 16 * mt + 4 * g + j; if (c < ntok) GO[(size_t)(r0 + c) * 1024 + h * 128 + sl * 32 + 16 * nt + c16] = f2bf(oacc[j]); } \
      _Pragma("unroll") for (int n2 = 0; n2 < 2; ++n2) { Sacc[n2] *= ring[CUR].eg; \
        _Pragma("unroll") for (int ks = 0; ks < 2; ++ks) { const bf16x8 bv = *(const LAS bf16x8*)(Vn + (16 * n2 + c16) * 72 + 32 * ks + 8 * g); Sacc[n2] = mfma16(ring[CUR].akd[ks], bv, Sacc[n2]); } \
        u32x2 pw; pw.x = pk2(Sacc[n2][0], Sacc[n2][1]); pw.y = pk2(Sacc[n2][2], Sacc[n2][3]); *(LAS u32x2*)(St + (16 * n2 + c16) * 136 + 16 * w + 4 * g) = pw; } \
      LDS_BARRIER(); } while (0)
    int ch3 = 0;
    for (; ch3 + 3 <= nch; ch3 += 3) { SCAN_STEP(0, 2, ch3); SCAN_STEP(1, 0, ch3 + 1); SCAN_STEP(2, 1, ch3 + 2); }
    if (ch3 < nch) SCAN_STEP(0, 2, ch3);
    if (ch3 + 1 < nch) SCAN_STEP(1, 0, ch3 + 1);
#undef SCAN_STEP
    float* So = p.out + (samp ? O_SSMS + (size_t)((seq - 2) * 8 + h) * 16384 : O_SSMP + (size_t)(seq * 8 + h) * 16384);
#pragma unroll
    for (int n2 = 0; n2 < 2; ++n2)
#pragma unroll
      for (int j = 0; j < 4; ++j) So[(size_t)(16 * w + 4 * g + j) * 128 + sl * 32 + 16 * n2 + c16] = Sacc[n2][j];
}
DI void pattn_item(const Params& p, int item, LAS unsigned char* lds, int tid) {
    unsigned char* ws = p.ws;
    const int qt = 15 - (item >> 4), b = (item >> 3) & 1, h = item & 7;
    const int w = tid >> 6, lane = tid & 63, g = lane >> 4, c16 = lane & 15;
    const int cq = 4 * qt + (w >> 1), nkt = 4 * qt + 4;
    LAS bf16_t* Kt = (LAS bf16_t*)lds;
    LAS bf16_t* Vt = Kt + 2 * 64 * 200;
    const bf16_t* KV = (const bf16_t*)(ws + OFF_KV) + (size_t)(b * 4096) * 2048 + h * 128;
    const bf16_t* KR = (const bf16_t*)(ws + OFF_KRB) + (size_t)(b * 4096) * 64;
    bf16x8 qf[2][6];
#pragma unroll
    for (int sb = 0; sb < 2; ++sb) { const bf16_t* q = (const bf16_t*)(ws + OFF_QP) + ((size_t)(b * 4096 + 256 * qt + 32 * w + 16 * sb + c16) * 8 + h) * 192 + 8 * g;
#pragma unroll
      for (int ks = 0; ks < 6; ++ks) qf[sb][ks] = *(const bf16x8*)(q + 32 * ks); }
    u32x4 ld[5];
    const int kr0 = tid >> 4, kc0 = (tid & 15) * 8;
    const int rr = tid >> 3, rc = (tid & 7) * 8;
#define PA_LOAD(kt) do { const size_t kb = (size_t)(kt) * 64; \
      ld[0] = *(const u32x4*)(KV + (kb + kr0) * 2048 + kc0); ld[1] = *(const u32x4*)(KV + (kb + kr0 + 32) * 2048 + kc0); \
      ld[2] = *(const u32x4*)(KV + (kb + kr0) * 2048 + 1024 + kc0); ld[3] = *(const u32x4*)(KV + (kb + kr0 + 32) * 2048 + 1024 + kc0); \
      ld[4] = *(const u32x4*)(KR + (kb + rr) * 64 + rc); } while (0)
#define PA_STORE(buf) do { LAS bf16_t* kd = Kt + (buf) * 64 * 200; LAS bf16_t* vd = Vt + (buf) * 64 * 144; \
      *(LAS u32x4*)(kd + kr0 * 200 + kc0) = ld[0]; *(LAS u32x4*)(kd + (kr0 + 32) * 200 + kc0) = ld[1]; \
      *(LAS u32x4*)(vd + kr0 * 144 + kc0) = ld[2]; *(LAS u32x4*)(vd + (kr0 + 32) * 144 + kc0) = ld[3]; \
      *(LAS u32x4*)(kd + rr * 200 + 128 + rc) = ld[4]; } while (0)
    PA_LOAD(0); PA_STORE(0);
    if (nkt > 1) PA_LOAD(1);
    __syncthreads();
    f32x4 oacc[2][8];
#pragma unroll
    for (int sb = 0; sb < 2; ++sb)
#pragma unroll
      for (int m = 0; m < 8; ++m) oacc[sb][m] = (f32x4){0.f, 0.f, 0.f, 0.f};
    float m_run[2] = {-1e30f, -1e30f}, l_run[2] = {0.f, 0.f};
    const int tq = c16 >> 2, tp = c16 & 3;
    for (int kt = 0; kt < nkt; ++kt) {
      const int buf = kt & 1;
      if (kt + 1 < nkt) { PA_STORE(buf ^ 1); if (kt + 2 < nkt) PA_LOAD(kt + 2); }
      if (kt <= cq) {
        const LAS bf16_t* kb = Kt + buf * 64 * 200; const LAS bf16_t* vb = Vt + buf * 64 * 144;
        f32x4 sacc[2][4];
#pragma unroll
        for (int t16 = 0; t16 < 4; ++t16) { bf16x8 kf[6];
#pragma unroll
          for (int ks = 0; ks < 6; ++ks) kf[ks] = *(const LAS bf16x8*)(kb + (16 * t16 + c16) * 200 + 32 * ks + 8 * g);
          sacc[0][t16] = (f32x4){0.f, 0.f, 0.f, 0.f}; sacc[1][t16] = (f32x4){0.f, 0.f, 0.f, 0.f};
#pragma unroll
          for (int ks = 0; ks < 6; ++ks) { sacc[0][t16] = mfma16(kf[ks], qf[0][ks], sacc[0][t16]); sacc[1][t16] = mfma16(kf[ks], qf[1][ks], sacc[1][t16]); } }
        bf16x8 pb[2][2];
#pragma unroll
        for (int sb = 0; sb < 2; ++sb) {
          float mx = sacc[sb][0][0];
#pragma unroll
          for (int t16 = 0; t16 < 4; ++t16)
#pragma unroll
            for (int j = 0; j < 4; ++j) mx = fmaxf(mx, sacc[sb][t16][j]);
          mx = fmaxf(mx, __shfl_xor(mx, 16)); mx = fmaxf(mx, __shfl_xor(mx, 32));
          const float mn = fmaxf(m_run[sb], mx), alpha = exp2f(m_run[sb] - mn); m_run[sb] = mn;
          float ps = 0.f;
#pragma unroll
          for (int t16 = 0; t16 < 4; ++t16)
#pragma unroll
            for (int j = 0; j < 4; ++j) { sacc[sb][t16][j] = exp2f(sacc[sb][t16][j] - mn); ps += sacc[sb][t16][j]; }
          l_run[sb] = l_run[sb] * alpha + ps;
#pragma unroll
          for (int m = 0; m < 8; ++m) oacc[sb][m] *= alpha;
#pragma unroll
          for (int s = 0; s < 2; ++s) { u32x4 pw; pw.x = pk2(sacc[sb][2 * s][0], sacc[sb][2 * s][1]); pw.y = pk2(sacc[sb][2 * s][2], sacc[sb][2 * s][3]); pw.z = pk2(sacc[sb][2 * s + 1][0], sacc[sb][2 * s + 1][1]); pw.w = pk2(sacc[sb][2 * s + 1][2], sacc[sb][2 * s + 1][3]);
            pb[sb][s] = __builtin_bit_cast(bf16x8, pw); } }
#pragma unroll
        for (int s = 0; s < 2; ++s)
#pragma unroll
          for (int mh = 0; mh < 2; ++mh) { s16x4 vf[4][2];
#pragma unroll
            for (int m4 = 0; m4 < 4; ++m4) { const int m = 4 * mh + m4; vf[m4][0] = tr_read(vb + (32 * s + 4 * g + tq) * 144 + 16 * m + 4 * tp); vf[m4][1] = tr_read(vb + (32 * s + 16 + 4 * g + tq) * 144 + 16 * m + 4 * tp); }
#pragma unroll
            for (int m4 = 0; m4 < 4; ++m4) { const int m = 4 * mh + m4; const bf16x8 va = __builtin_shufflevector(vf[m4][0], vf[m4][1], 0, 1, 2, 3, 4, 5, 6, 7);
              oacc[0][m] = mfma16(va, pb[0][s], oacc[0][m]); oacc[1][m] = mfma16(va, pb[1][s], oacc[1][m]); } }
      }
      __syncthreads();
    }
#undef PA_LOAD
#undef PA_STORE
#pragma unroll
    for (int sb = 0; sb < 2; ++sb) { float l = l_run[sb]; l += __shfl_xor(l, 16); l += __shfl_xor(l, 32);
      const float il = 1.0f / l;
      bf16_t* o = (bf16_t*)(ws + OFF_OM) + (size_t)(b * 4096 + 256 * qt + 32 * w + 16 * sb + c16) * 1024 + h * 128 + 4 * g;
#pragma unroll
      for (int m = 0; m < 8; ++m) { u32x2 pw; pw.x = pk2(oacc[sb][m][0] * il, oacc[sb][m][1] * il); pw.y = pk2(oacc[sb][m][2] * il, oacc[sb][m][3] * il); *(u32x2*)(o + 16 * m) = pw; } }
}

DI void sattn_item(const Params& p, int item, LAS unsigned char* lds, int tid) {
    unsigned char* ws = p.ws;
    const int b = item >> 4, hg = (item >> 2) & 3, sp = item & 3;
    const int w = tid >> 6, lane = tid & 63, g = lane >> 4, c16 = lane & 15, qs = w & 3, dh = w >> 2;
    LAS bf16_t* Qs = (LAS bf16_t*)lds;
    LAS bf16_t* Kt = Qs + 64 * 584;
    const int t_lo = sp * 32, t_hi = sp == 3 ? 129 : sp * 32 + 32;
    const float* ck = p.in[4] + (size_t)b * 4096 * 512; const float* kr = p.in[5] + (size_t)b * 4096 * 64;
    const bf16_t* ckn = (const bf16_t*)(ws + OFF_CKVB) + (size_t)(MPR + b * 32) * 512; const bf16_t* krn = (const bf16_t*)(ws + OFF_KRB) + (size_t)(MPR + b * 32) * 64;
    { const bf16_t* q0 = (const bf16_t*)(ws + OFF_QS) + (size_t)(b * 8 + 2 * hg) * 32 * 576;
      const int row = tid >> 3, c = tid & 7;
#pragma unroll
      for (int i = 0; i < 9; ++i) *(LAS u32x4*)(Qs + row * 584 + (c + 8 * i) * 8) = *(const u32x4*)(q0 + (size_t)row * 576 + (c + 8 * i) * 8); }
    float4 ld[9];
    const int lk = tid >> 7, lc = tid & 127, rk = tid >> 4, rc4 = tid & 15;
#define SA_LOAD(tile) do { if ((tile) < 128) { const float* s_ = ck + (size_t)((tile) * 32 + lk) * 512 + lc * 4; \
        _Pragma("unroll") for (int i = 0; i < 8; ++i) ld[i] = *(const float4*)(s_ + i * 2048); \
        ld[8] = *(const float4*)(kr + (size_t)((tile) * 32 + rk) * 64 + rc4 * 4); } \
      else { const bf16_t* s_ = ckn + lk * 512 + lc * 4; \
        _Pragma("unroll") for (int i = 0; i < 8; ++i) { const u32x2 v = *(const u32x2*)(s_ + i * 2048); ld[i] = make_float4(bflo(v.x), bfhi(v.x), bflo(v.y), bfhi(v.y)); } \
        const u32x2 v = *(const u32x2*)(krn + rk * 64 + rc4 * 4); ld[8] = make_float4(bflo(v.x), bfhi(v.x), bflo(v.y), bfhi(v.y)); } } while (0)
#define SA_STORE(buf) do { LAS bf16_t* kd = Kt + (buf) * 32 * 584; \
        _Pragma("unroll") for (int i = 0; i < 8; ++i) { u32x2 v; v.x = pk2(ld[i].x, ld[i].y); v.y = pk2(ld[i].z, ld[i].w); *(LAS u32x2*)(kd + (lk + 4 * i) * 584 + lc * 4) = v; } \
        { u32x2 v; v.x = pk2(ld[8].x, ld[8].y); v.y = pk2(ld[8].z, ld[8].w); *(LAS u32x2*)(kd + rk * 584 + 512 + rc4 * 4) = v; } } while (0)
    SA_LOAD(t_lo); SA_STORE(0);
    SA_LOAD(t_lo + 1);
    __syncthreads();
    f32x4 oacc[16];
#pragma unroll
    for (int m = 0; m < 16; ++m) oacc[m] = (f32x4){0.f, 0.f, 0.f, 0.f};
    float m_run = -1e30f, l_run = 0.f;
    const int tq = c16 >> 2, tp = c16 & 3;
    for (int tile = t_lo; tile < t_hi; ++tile) {
      const int buf = (tile - t_lo) & 1;
      if (tile + 1 < t_hi) { SA_STORE(buf ^ 1); if (tile + 2 < t_hi) SA_LOAD(tile + 2); }
      const LAS bf16_t* kb = Kt + buf * 32 * 584;
      f32x4 sacc[2] = {(f32x4){0.f, 0.f, 0.f, 0.f}, (f32x4){0.f, 0.f, 0.f, 0.f}};
      bf16x8 fr[2][2][3];
#define SA_FRAGS(dst, grp) do { _Pragma("unroll") for (int k6 = 0; k6 < 2; ++k6) { const int ks = (grp) * 2 + k6; \
        dst[k6][0] = *(const LAS bf16x8*)(Qs + (16 * qs + c16) * 584 + 32 * ks + 8 * g); \
        dst[k6][1] = *(const LAS bf16x8*)(kb + c16 * 584 + 32 * ks + 8 * g); dst[k6][2] = *(const LAS bf16x8*)(kb + (16 + c16) * 584 + 32 * ks + 8 * g); } } while (0)
      SA_FRAGS(fr[0], 0);
#pragma unroll
      for (int grp = 0; grp < 9; ++grp) {
        if (grp < 8) SA_FRAGS(fr[(grp + 1) & 1], grp + 1);
        __builtin_amdgcn_sched_barrier(0);
#pragma unroll
        for (int k6 = 0; k6 < 2; ++k6) { sacc[0] = mfma16(fr[grp & 1][k6][1], fr[grp & 1][k6][0], sacc[0]); sacc[1] = mfma16(fr[grp & 1][k6][2], fr[grp & 1][k6][0], sacc[1]); }
        __builtin_amdgcn_sched_barrier(0); }
#undef SA_FRAGS
      float mx = sacc[0][0];
#pragma unroll
      for (int t16 = 0; t16 < 2; ++t16)
#pragma unroll
        for (int j = 0; j < 4; ++j) mx = fmaxf(mx, sacc[t16][j]);
      mx = fmaxf(mx, __shfl_xor(mx, 16)); mx = fmaxf(mx, __shfl_xor(mx, 32));
      const float mn = fmaxf(m_run, mx), alpha = exp2f(m_run - mn); m_run = mn;
      float ps = 0.f;
#pragma unroll
      for (int t16 = 0; t16 < 2; ++t16)
#pragma unroll
        for (int j = 0; j < 4; ++j) { sacc[t16][j] = exp2f(sacc[t16][j] - mn); ps += sacc[t16][j]; }
      l_run = l_run * alpha + ps;
      u32x4 pw; pw.x = pk2(sacc[0][0], sacc[0][1]); pw.y = pk2(sacc[0][2], sacc[0][3]); pw.z = pk2(sacc[1][0], sacc[1][1]); pw.w = pk2(sacc[1][2], sacc[1][3]);
      const bf16x8 pb = __builtin_bit_cast(bf16x8, pw);
      s16x4 vf[2][4][2];
#define SA_VF(dst, q4) do { _Pragma("unroll") for (int m = 0; m < 4; ++m) { dst[m][0] = tr_read(kb + (4 * g + tq) * 584 + 256 * dh + 16 * (4 * (q4) + m) + 4 * tp); \
        dst[m][1] = tr_read(kb + (16 + 4 * g + tq) * 584 + 256 * dh + 16 * (4 * (q4) + m) + 4 * tp); } } while (0)
      SA_VF(vf[0], 0);
#pragma unroll
      for (int q4 = 0; q4 < 4; ++q4) {
        if (q4 < 3) SA_VF(vf[(q4 + 1) & 1], q4 + 1);
#pragma unroll
        for (int m = 0; m < 4; ++m) oacc[4 * q4 + m] *= alpha;
        __builtin_amdgcn_sched_barrier(0);
#pragma unroll
        for (int m = 0; m < 4; ++m) { const bf16x8 va = __builtin_shufflevector(vf[q4 & 1][m][0], vf[q4 & 1][m][1], 0, 1, 2, 3, 4, 5, 6, 7); oacc[4 * q4 + m] = mfma16(va, pb, oacc[4 * q4 + m]); }
        __builtin_amdgcn_sched_barrier(0); }
#undef SA_VF
      __syncthreads();
    }
#undef SA_LOAD
#undef SA_STORE
    l_run += __shfl_xor(l_run, 16); l_run += __shfl_xor(l_run, 32);
    const int qrow = 16 * qs + c16, h = 2 * hg + (qrow >> 5), t = qrow & 31;
    const size_t prow = (size_t)((b * 8 + h) * 4 + sp) * 32 + t;
    bf16_t* po = (bf16_t*)(ws + OFF_PO) + prow * 512 + 256 * dh + 4 * g;
#pragma unroll
    for (int m = 0; m < 16; ++m) { u32x2 pw; pw.x = pk2(oacc[m][0], oacc[m][1]); pw.y = pk2(oacc[m][2], oacc[m][3]); *(u32x2*)(po + 16 * m) = pw; }
    if (dh == 0 && g == 0) { float* ml = (float*)(ws + OFF_ML) + prow * 2; ml[0] = m_run; ml[1] = l_run; }
}

DI void og_row(const Params& p, int r, int lane) {
    unsigned char* ws = p.ws;
    const bf16_t* o = (const bf16_t*)(ws + OFF_GO) + (size_t)r * 1024 + lane * 16;
    float x[16]; unpack8(*(const u32x4*)o, x); unpack8(*(const u32x4*)(o + 8), x + 8);
    float ss = 0.f;
#pragma unroll
    for (int c = 0; c < 16; ++c) ss += x[c] * x[c];
    ss += __shfl_xor(ss, 1); ss += __shfl_xor(ss, 2); ss += __shfl_xor(ss, 4);
    const float rn = rsqrtf(ss * (1.0f / 128.0f) + NEPS);
    const bf16_t* z = (const bf16_t*)(ws + OFF_R1) + (size_t)r * DINP + C_Z + lane * 16;
    float zz[16]; unpack8(*(const u32x4*)z, zz); unpack8(*(const u32x4*)(z + 8), zz + 8);
    const float* gw = p.in[16] + (lane & 7) * 16;
#pragma unroll
    for (int c = 0; c < 16; ++c) x[c] = x[c] * rn * gw[c] * silu_f(zz[c]);
    bf16_t* og = (bf16_t*)(ws + OFF_OG) + (size_t)r * 1024 + lane * 16;
    *(u32x4*)og = pack8(x); *(u32x4*)(og + 8) = pack8(x + 8);
}
DI void scomb_item(const Params& p, int b, int h, LAS bf16_t* ol, int tid) {
    unsigned char* ws = p.ws;
    const bf16_t* PO = (const bf16_t*)(ws + OFF_PO) + (size_t)((b * 8 + h) * 4) * 32 * 512; const float* ML = (const float*)(ws + OFF_ML) + (size_t)((b * 8 + h) * 4) * 32 * 2;
#pragma unroll 4
    for (int t = 0; t < 32; ++t) { float m[4], l[4], mx = -1e30f;
#pragma unroll
      for (int s = 0; s < 4; ++s) { m[s] = ML[(s * 32 + t) * 2]; l[s] = ML[(s * 32 + t) * 2 + 1]; mx = fmaxf(mx, m[s]); }
      float L = 0.f, acc = 0.f;
#pragma unroll
      for (int s = 0; s < 4; ++s) { const float ws_ = exp2f(m[s] - mx); L += ws_ * l[s]; acc += ws_ * bf2f(PO[(size_t)(s * 32 + t) * 512 + tid]); }
      ol[t * 520 + tid] = f2bf(acc / L); }
    __syncthreads();
    const int w = tid >> 6, lane = tid & 63, g = lane >> 4, c16 = lane & 15;
    const bf16_t* wt = (const bf16_t*)(ws + OFF_WUV) + (size_t)(h * 128 + 16 * w + c16) * 512 + 8 * g;
    bf16x8 wb[16];
#pragma unroll
    for (int ks = 0; ks < 16; ++ks) wb[ks] = *(const bf16x8*)(wt + 32 * ks);
    f32x4 acc[2] = {(f32x4){0.f, 0.f, 0.f, 0.f}, (f32x4){0.f, 0.f, 0.f, 0.f}};
#pragma unroll
    for (int ks = 0; ks < 16; ++ks)
#pragma unroll
      for (int mt = 0; mt < 2; ++mt) { const bf16x8 a = *(const LAS bf16x8*)(ol + (16 * mt + c16) * 520 + 32 * ks + 8 * g); acc[mt] = mfma16(a, wb[ks], acc[mt]); }
    bf16_t* om = (bf16_t*)(ws + OFF_OM) + (size_t)(MPR + b * 32) * 1024 + h * 128 + 16 * w + c16;
#pragma unroll
    for (int mt = 0; mt < 2; ++mt)
#pragma unroll
      for (int j = 0; j < 4; ++j) om[(size_t)(16 * mt + 4 * g + j) * 1024] = f2bf(acc[mt][j]);
    __syncthreads();
}
#ifndef GEMM_SP2
#define GEMM_SP2 true
#endif
#ifndef GEMM_ALIGN
#define GEMM_ALIGN true
#endif
template <class Epi>
DI void run_gemm(LAS unsigned char* lds, const bf16_t* A, const bf16_t* Bt, int M, int N, int K, const Epi& E, int G, int c) {
    pg8::Gemm g{A, Bt, M, N, K, K, K}; pg8::StaticOrder S; S.init(M, N, G, c);
    pg8::gemm_phase<Epi, pg8::StaticOrder, GEMM_ALIGN, GEMM_SP2>((PG8_LAS unsigned char*)lds, g, S, E);
}
struct OneUnit { int pm, pn;
    DI bool next(int i, pg8::Unit& u) const { if (i) return false; u.pm = pm; u.pn = pn; return true; }
    DI void a_ready(const pg8::Unit&) const {}
    DI void done(const pg8::Unit&) const {} };
template <class Epi>
DI void run_gemm_split_e(LAS unsigned char* lds, const bf16_t* A, const bf16_t* Bt, int K, int ksub, const Epi& E, int c) {
    const int s = c >> 4, u = c & 15;
    pg8::Gemm g{A + (size_t)s * ksub, Bt + (size_t)s * ksub, MT, D, ksub, K, K}; OneUnit S{32 + (u >> 3), u & 7};
    pg8::gemm_phase<Epi, OneUnit, GEMM_ALIGN, GEMM_SP2>((PG8_LAS unsigned char*)lds, g, S, E);
}
DI void run_gemm_split(LAS unsigned char* lds, const bf16_t* A, const bf16_t* Bt, int K, int ksub, float* part, int c) {
    const int nsplit = K / ksub;
    if (c >= 16 * nsplit) return;
    pg8::EpiBf16P E{(bf16_t*)part + (size_t)(c >> 4) * 512 * D - (size_t)MPR * D, D};
    run_gemm_split_e(lds, A, Bt, K, ksub, E, c);
}
#ifndef REP_PREP
#define REP_PREP 1
#endif
#ifndef REP_SCAN
#define REP_SCAN 1
#endif
#ifndef REP_PATTN
#define REP_PATTN 1
#endif
#ifndef REP_SATTN
#define REP_SATTN 1
#endif
#ifndef REP_P0
#define REP_P0 1
#endif
#ifndef REP_P1
#define REP_P1 1
#endif
#ifndef REP_P5
#define REP_P5 1
#endif
#ifndef REP_P7
#define REP_P7 1
#endif
__global__ void __launch_bounds__(512, 2) fwd_megakernel(Params p) {
    extern __shared__ __attribute__((aligned(16))) unsigned char smem[];
    LAS unsigned char* lds = (LAS unsigned char*)smem;
    cg::grid_group grid = cg::this_grid();
    int tid = threadIdx.x, lane = tid & 63, wv = tid >> 6; const int G = gridDim.x, bid = blockIdx.x;
#define FRESH_TID() do { tid = threadIdx.x; asm volatile("" : "+v"(tid)); lane = tid & 63; wv = tid >> 6; } while (0)
    unsigned char* ws = p.ws;
    bf16_t* XN = (bf16_t*)(ws + OFF_XN); bf16_t* R1 = (bf16_t*)(ws + OFF_R1); float* F = (float*)(ws + OFF_F); float* Y = p.out;
    unsigned* ctl = (unsigned*)(ws + OFF_CTL); float* FP = (float*)(ws + OFF_KV); bf16_t* FB = (bf16_t*)(ws + OFF_F); bf16_t* XB2 = (bf16_t*)(ws + OFF_GP); bf16_t* XB1 = (bf16_t*)p.out;
    LAS int* s_item = (LAS int*)(lds + LDS_CTL);
    if (tid < 8) ((LAS unsigned*)(lds + LDS_CTL))[tid] = 0u;
    __syncthreads();
    if (p.out == nullptr) grid.sync();
    XcdBarrier xb = xcd_barrier_post((unsigned*)(ws + OFF_BAR), (volatile LAS unsigned*)(lds + LDS_CTL + 16));

#define DRAIN_TR() do { for (;;) { __syncthreads(); if (tid == 0) *s_item = (int)atomicAdd(ctl + 2, 1u); __syncthreads(); const int q_ = *s_item; if (q_ >= 2112) break; \
      bool any_; transpose_pass4((LAS float*)lds, p, q_ * 4, tjob_p3, tid, any_); } } while (0)
#define DRAIN_LATE() do { for (;;) { __syncthreads(); if (tid == 0) *s_item = (int)atomicAdd(ctl + 3, 1u); __syncthreads(); const int q_ = *s_item; if (q_ >= 640) break; \
      bool any_; transpose_pass4((LAS float*)lds, p, q_ * 4, tjob_late, tid, any_); } } while (0)
#define DRAIN_WIN() do { for (;;) { __syncthreads(); if (tid == 0) *s_item = (int)atomicAdd(ctl + 4, 1u); __syncthreads(); const int q_ = *s_item; if (q_ >= 1296) break; \
      bool any_; transpose_pass4((LAS float*)lds, p, q_ * 4, tjob_win, tid, any_); } } while (0)
    if (tid == 0) { const unsigned x = (unsigned)__builtin_amdgcn_s_getreg((3 << 11) | 20) & 0xFu; const unsigned slot = atomicAdd(ctl + 16 + (x & 7u), 1u); s_item[1] = (int)(slot * 8u + (x & 7u)); }
    for (int r = bid * 8 + wv; r < MT; r += G * 8) rowop<false, false, true>(xin_row(p, r), nullptr, nullptr, 0, 0.f, nullptr, p.in[6], nullptr, XN + (size_t)r * D, lane);
    _Pragma("unroll") for (int rep = 0; rep < REP_P0; ++rep) {
    for (int t = bid * 4;; t += G * 4) { bool any; transpose_pass4((LAS float*)lds, p, t, tjob_p0, tid, any); if (!any) break; }
    xcd_barrier(xb); FRESH_TID(); }
    int gid = bid;
    { bool ok = (G % 8) == 0;
      for (int x = 0; x < 8; ++x) ok = ok && (__hip_atomic_load(ctl + 16 + x, __ATOMIC_RELAXED, __HIP_MEMORY_SCOPE_AGENT) == (unsigned)(G / 8));
      if (ok) gid = s_item[1]; }
    gid = __builtin_amdgcn_readfirstlane(gid);
    _Pragma("unroll") for (int rep = 0; rep < REP_P1; ++rep) {
    { pg8::EpiSwiglu E{R1, DFF}; run_gemm(lds, XN, (const bf16_t*)(ws + OFF_WGU), MT, 2 * DFF, D, E, G, gid); }
    DRAIN_LATE(); DRAIN_WIN();
    xcd_barrier(xb); FRESH_TID(); }
    { pg8::EpiBf16P E{FB, D}; run_gemm(lds, R1, (const bf16_t*)(ws + OFF_WD), MPR, D, DFF, E, G, gid); }
    __syncthreads();
    run_gemm_split(lds, R1, (const bf16_t*)(ws + OFF_WD), DFF, 512, FP, G - 1 - gid);
    __syncthreads(); DRAIN_WIN();
    xcd_barrier(xb); FRESH_TID();
    for (int r = bid * 8 + wv; r < MT; r += G * 8) rowop<true, true, true, false, true>(xin_row(p, r), r < MPR ? nullptr : (const float*)((const bf16_t*)FP + (size_t)(r - MPR) * D), r < MPR ? FB + (size_t)r * D : nullptr, r < MPR ? 1 : 11, 0.5f, p.in[10], p.in[11], nullptr, XN + (size_t)r * D, lane, nullptr, XB1 + (size_t)r * D);
    DRAIN_WIN();
    xcd_barrier(xb); FRESH_TID();
    { pg8::EpiBf16P E{R1, DINP}; run_gemm(lds, XN, (const bf16_t*)(ws + OFF_WIN), MT, DINP, D, E, G, gid); }
    DRAIN_LATE();
    DRAIN_TR();
    xcd_barrier(xb); FRESH_TID();
    _Pragma("unroll") for (int rep = 0; rep < REP_P5; ++rep) {
    for (int r = bid * 8 + wv; r < MT; r += G * 8) mla_prep_row(p, r, lane);
    for (int i = bid * 512 + tid; i < 18 * 3 * 3072; i += G * 512) { const int seq = i / 9216, rem = i % 9216, jr = rem / 3072, c = rem % 3072;
        const int row = seq < 2 ? seq * 4096 + 4093 + jr : MPR + (seq - 2) * 32 + 29 + jr;
        const float v = bf2f(R1[(size_t)row * DINP + c]);
        if (seq < 2) Y[O_CONVP + (size_t)(seq * 3 + jr) * 3072 + c] = v; else Y[O_CONVS + (size_t)((seq - 2) * 3 + jr) * 3072 + c] = v; }
#ifndef SK_QLAT
    for (int it = bid; it < 128; it += G) qlat_item(p, it >> 3, it & 7, tid);
#endif
#ifndef SK_PREP
    for (int rp = 0; rp < REP_PREP; ++rp)
    for (int it = bid; it < 1152; it += G) gdn_prep_item(p, it, lds, tid);
#endif
    xcd_barrier(xb); FRESH_TID(); }
    { pg8::EpiBf16P E{(bf16_t*)(ws + OFF_KV), 2048}; run_gemm(lds, (const bf16_t*)(ws + OFF_CKVB), (const bf16_t*)(ws + OFF_WUK), MPR, 2048, 512, E, G, gid); }
    xcd_barrier(xb); FRESH_TID();
    _Pragma("unroll") for (int rep = 0; rep < REP_P7; ++rep) {
#define FETCH_ITEM() do { __syncthreads(); if (tid == 0) *s_item = (int)atomicAdd(ctl + rep, 1u); __syncthreads(); it = *s_item; } while (0)
    {
      for (int i0 = gid; i0 < 64; i0 += G) { const int sit = ((i0 & 7) + 8 * (i0 >> 5)) * 4 + ((i0 >> 3) & 3); scan_item(p, sit, lds, tid); __syncthreads(); }
      int it; FETCH_ITEM();
      while (it < 128) { pattn_item(p, it, lds, tid); FETCH_ITEM(); }
      while (it < 384) { sattn_item(p, it - 128, lds, tid); FETCH_ITEM(); }
      while (it < 512) { pattn_item(p, it - 384 + 128, lds, tid); FETCH_ITEM(); }
      while (it < 1024) { scan_item(p, 64 + (it - 512), lds, tid); FETCH_ITEM(); }
    }
    DRAIN_TR();
    xcd_barrier(xb); FRESH_TID(); }
    for (int r = bid * 8 + wv; r < MT; r += G * 8) og_row(p, r, lane);
#ifndef SK_SCOMB
    for (int it = bid; it < 128; it += G) scomb_item(p, it >> 3, it & 7, (LAS bf16_t*)lds, tid);
#endif
    xcd_barrier(xb); FRESH_TID();
    { pg8::EpiGate1 E{FB, D, R1 + C_GG, DINP}; run_gemm(lds, (const bf16_t*)(ws + OFF_OG), (const bf16_t*)(ws + OFF_WBRG), MPR, D, 1024, E, G, gid); }
    __syncthreads();
    { pg8::EpiGate2 E{XN, D, FB, R1 + C_GM, DINP}; run_gemm(lds, (const bf16_t*)(ws + OFF_OM), (const bf16_t*)(ws + OFF_WBRM), MPR, D, 1024, E, G, gid); }
    __syncthreads();
    { const int c = G - 1 - gid;
      if (c < 64) { pg8::EpiGate1 E{(bf16_t*)FP + (size_t)(c >> 4) * 512 * D - (size_t)MPR * D, D, R1 + C_GG, DINP}; run_gemm_split_e(lds, (const bf16_t*)(ws + OFF_OG), (const bf16_t*)(ws + OFF_WBRG), 1024, 256, E, c); }
      else if (c < 128) { const int c2 = c - 64; pg8::EpiGate1 E{(bf16_t*)FP + (size_t)(4 + (c2 >> 4)) * 512 * D - (size_t)MPR * D, D, R1 + C_GM, DINP}; run_gemm_split_e(lds, (const bf16_t*)(ws + OFF_OM), (const bf16_t*)(ws + OFF_WBRM), 1024, 256, E, c2); } }
    xcd_barrier(xb); FRESH_TID();
    for (int r = bid * 8 + wv; r < 512; r += G * 8) {
      float4 v[8]; const bf16_t* fpb = (const bf16_t*)FP + (size_t)r * D;
#pragma unroll
      for (int i = 0; i < 8; ++i) { const u32x2 t = *(const u32x2*)(fpb + (i * 64 + lane) * 4); v[i] = make_float4(bflo(t.x), bfhi(t.x), bflo(t.y), bfhi(t.y)); }
#pragma unroll 1
      for (int s2 = 1; s2 < 8; ++s2) {
#pragma unroll
        for (int i = 0; i < 8; ++i) { const u32x2 t = *(const u32x2*)(fpb + (size_t)s2 * 512 * D + (i * 64 + lane) * 4); v[i].x += bflo(t.x); v[i].y += bfhi(t.x); v[i].z += bflo(t.y); v[i].w += bfhi(t.y); } }
#pragma unroll
      for (int i = 0; i < 8; ++i) { u32x2 pw; pw.x = pk2(v[i].x, v[i].y); pw.y = pk2(v[i].z, v[i].w); *(u32x2*)(XN + (size_t)(MPR + r) * D + (i * 64 + lane) * 4) = pw; } }
    xcd_barrier(xb); FRESH_TID();
    { pg8::EpiBf16P E{FB, D}; run_gemm(lds, XN, (const bf16_t*)(ws + OFF_WOUT), MPR, D, D, E, G, gid); }
    __syncthreads();
    run_gemm_split(lds, XN, (const bf16_t*)(ws + OFF_WOUT), D, 256, FP, G - 1 - gid);
    xcd_barrier(xb); FRESH_TID();
    for (int r = bid * 8 + wv; r < MT; r += G * 8) rowop<true, true, true, true, true>(nullptr, r < MPR ? nullptr : (const float*)((const bf16_t*)FP + (size_t)(r - MPR) * D), r < MPR ? FB + (size_t)r * D : nullptr, r < MPR ? 1 : 8, 1.0f, p.in[23], p.in[24], nullptr, XN + (size_t)r * D, lane, XB1 + (size_t)r * D, XB2 + (size_t)r * D);
    DRAIN_TR();
    xcd_barrier(xb); FRESH_TID();
    { pg8::EpiSwiglu E{R1, DFF}; run_gemm(lds, XN, (const bf16_t*)(ws + OFF_WGU), MT, 2 * DFF, D, E, G, gid); }
    xcd_barrier(xb); FRESH_TID();
    { pg8::EpiBf16P E{FB, D}; run_gemm(lds, R1, (const bf16_t*)(ws + OFF_WD), MPR, D, DFF, E, G, gid); }
    __syncthreads();
    run_gemm_split(lds, R1, (const bf16_t*)(ws + OFF_WD), DFF, 512, FP, G - 1 - gid);
    xcd_barrier(xb); FRESH_TID();
    for (int r = bid * 8 + wv; r < MT; r += G * 8) rowop<true, true, false, true, false>(nullptr, r < MPR ? nullptr : (const float*)((const bf16_t*)FP + (size_t)(r - MPR) * D), r < MPR ? FB + (size_t)r * D : nullptr, r < MPR ? 1 : 11, 0.5f, p.in[28], nullptr, Y + (size_t)r * D, nullptr, lane, XB2 + (size_t)r * D);
}

extern "C" void kernel_launch(void* const* d_in, const int* in_sizes, int n_in, void* d_out, int out_size, void* d_ws, size_t ws_size, hipStream_t stream) {
    static int grid_blocks = 0;
    if (grid_blocks == 0) {
        int dev = 0, cus = 0, per_cu = 0;
        hipGetDevice(&dev);
        hipDeviceGetAttribute(&cus, hipDeviceAttributeMultiprocessorCount, dev);
        if (hipFuncSetAttribute((const void*)fwd_megakernel, hipFuncAttributeMaxDynamicSharedMemorySize, LDS_BYTES) != hipSuccess) fprintf(stderr, "kernel_launch: hipFuncSetAttribute failed\n");
        if (hipOccupancyMaxActiveBlocksPerMultiprocessor(&per_cu, (const void*)fwd_megakernel, 512, LDS_BYTES) != hipSuccess || per_cu < 1) { fprintf(stderr, "kernel_launch: occupancy query gave %d\n", per_cu); per_cu = 1; }
        (void)hipGetLastError();
        grid_blocks = cus * (per_cu > 1 ? 1 : per_cu);
        if (ws_size < WS_END + 16384) fprintf(stderr, "kernel_launch: workspace too small: %zu < %zu\n", ws_size, (size_t)WS_END);
        if (n_in != 29) fprintf(stderr, "kernel_launch: expected 29 inputs, got %d\n", n_in);
    }
    if (hipMemsetAsync((unsigned char*)d_ws + OFF_BAR, 0, 16384, stream) != hipSuccess) fprintf(stderr, "kernel_launch: memset failed\n");
    if (hipMemsetAsync((unsigned char*)d_ws + OFF_CTL, 0, 4096, stream) != hipSuccess) fprintf(stderr, "kernel_launch: memset failed\n");
    Params p{};
    for (int i = 0; i < 29; ++i) p.in[i] = (const float*)d_in[i];
    p.out = (float*)d_out; p.ws = (unsigned char*)d_ws;
    void* args[] = {&p};
    hipError_t e = hipLaunchCooperativeKernel((const void*)fwd_megakernel, dim3(grid_blocks), dim3(512), args, LDS_BYTES, stream);
    if (e != hipSuccess) fprintf(stderr, "kernel_launch: cooperative launch failed: %s (grid %d)\n", hipGetErrorString(e), grid_blocks);
}
```
